# Optimizing an MI355X kernel written in HIP

```python
import math
import jax
import jax.numpy as jnp
from jax import lax
import numpy as np

D_MODEL = 1024
BATCH = 8
SEQ = 4096
DEPTH = 4

GRID_W = 64
EPS = 1e-6

S5_WIDTH = D_MODEL // 2
S5_GROUP = 16
S5_GROUPS = S5_WIDTH // S5_GROUP
S5_STATE = 64
S5_MAX_RE = -1e-4

HEAD_DIM = 64
N_Q_HEADS = (D_MODEL // 2) // HEAD_DIM
N_KV_HEADS = 2
Q_PER_KV = N_Q_HEADS // N_KV_HEADS
ATTN_WIDTH = N_Q_HEADS * HEAD_DIM
KV_WIDTH = N_KV_HEADS * HEAD_DIM
ROPE_AXIS_DIM = HEAD_DIM // 2
ROPE_FREQS = ROPE_AXIS_DIM // 2
ROPE_BASE = 10000.0
Q_BLOCK = 128

HYB_IN = S5_WIDTH + ATTN_WIDTH + 2 * KV_WIDTH
HYB_OUT = S5_WIDTH + ATTN_WIDTH

LRU_WIDTH = D_MODEL
LRU_HEADS = 16
LRU_BLOCK = LRU_WIDTH // LRU_HEADS
CONV_WIDTH = 4
CONV_LEFT = 2
LRU_C = 8.0

D_FF = 4 * D_MODEL

N_EVEN = (DEPTH + 1) // 2
N_ODD = DEPTH // 2

kernel_name = "hybrid_s5_gqa_rglru_encoder"


def rms_norm(x, w):
    xf = x.astype(jnp.float32)
    y = xf * lax.rsqrt(jnp.mean(xf * xf, axis=-1, keepdims=True) + EPS)
    return (y * w.astype(jnp.float32)).astype(x.dtype)


def _linear_combine(e1, e2):
    a1, b1 = e1
    a2, b2 = e2
    return a1 * a2, a2 * b1 + b2


def _complex_linear_combine(e1, e2):
    ar1, ai1, br1, bi1 = e1
    ar2, ai2, br2, bi2 = e2
    return (ar1 * ar2 - ai1 * ai2,
            ar1 * ai2 + ai1 * ar2,
            ar2 * br1 - ai2 * bi1 + br2,
            ar2 * bi1 + ai2 * br1 + bi2)


def s5_mixer(u, lam_re, lam_im, log_dt, b_re, b_im, c_re, c_im, d, glu_w, glu_b):
    bsz, seq, _ = u.shape
    f32 = jnp.float32
    uf = u.astype(f32).reshape(bsz, seq, S5_GROUPS, S5_GROUP)
    y = uf * d.astype(f32).reshape(S5_GROUPS, S5_GROUP)
    for direction in range(2):
        lr = jnp.minimum(lam_re[direction].astype(f32), S5_MAX_RE)
        li = lam_im[direction].astype(f32)
        dt = jnp.exp(log_dt[direction].astype(f32))[:, None]
        mag = jnp.exp(lr * dt)
        abar_re = mag * jnp.cos(li * dt)
        abar_im = mag * jnp.sin(li * dt)
        den = lr * lr + li * li
        nr = abar_re - 1.0
        f_re = (nr * lr + abar_im * li) / den
        f_im = (abar_im * lr - nr * li) / den
        br = b_re[direction].astype(f32)
        bi = b_im[direction].astype(f32)
        bb_re = f_re[..., None] * br - f_im[..., None] * bi
        bb_im = f_re[..., None] * bi + f_im[..., None] * br
        bu_re = jnp.einsum("bsgc,gpc->bsgp", uf, bb_re)
        bu_im = jnp.einsum("bsgc,gpc->bsgp", uf, bb_im)
        a_shape = (1, seq, S5_GROUPS, S5_STATE)
        _, _, h_re, h_im = lax.associative_scan(
            _complex_linear_combine,
            (jnp.broadcast_to(abar_re, a_shape), jnp.broadcast_to(abar_im, a_shape), bu_re, bu_im),
            reverse=(direction == 1), axis=1)
        y = y + (jnp.einsum("bsgp,gcp->bsgc", h_re, c_re[direction].astype(f32))
                 - jnp.einsum("bsgp,gcp->bsgc", h_im, c_im[direction].astype(f32)))
    y = y.reshape(bsz, seq, S5_WIDTH)
    g = jax.nn.gelu(y)
    out = g * jax.nn.sigmoid(g @ glu_w.astype(f32) + glu_b.astype(f32))
    return out.astype(u.dtype)


def axial_rope_tables(seq):
    rows = seq // GRID_W
    row_idx = jnp.repeat(jnp.arange(rows, dtype=jnp.float32), GRID_W)
    col_idx = jnp.tile(jnp.arange(GRID_W, dtype=jnp.float32), rows)
    inv_freq = ROPE_BASE ** (-jnp.arange(ROPE_FREQS, dtype=jnp.float32) / ROPE_FREQS)
    ang = jnp.stack([row_idx[:, None] * inv_freq, col_idx[:, None] * inv_freq], axis=1)
    return jnp.cos(ang), jnp.sin(ang)


def apply_axial_rope(x, cos, sin):
    shp = x.shape
    xs = x.reshape(shp[0], shp[1], shp[2], 2, 2, ROPE_FREQS)
    x1, x2 = xs[..., 0, :], xs[..., 1, :]
    c = cos[None, :, None]
    s = sin[None, :, None]
    return jnp.stack([x1 * c - x2 * s, x2 * c + x1 * s], axis=-2).reshape(shp)


def axial_gqa(q, k, v, q_norm, k_norm, cos, sin):
    bsz, seq, _ = q.shape
    f32 = jnp.float32
    qf = rms_norm(q.astype(f32).reshape(bsz, seq, N_Q_HEADS, HEAD_DIM), q_norm)
    kf = rms_norm(k.astype(f32).reshape(bsz, seq, N_KV_HEADS, HEAD_DIM), k_norm)
    qf = apply_axial_rope(qf, cos, sin) * (HEAD_DIM ** -0.5)
    kf = apply_axial_rope(kf, cos, sin)
    vf = v.astype(f32).reshape(bsz, seq, N_KV_HEADS, HEAD_DIM)
    n_blk = seq // Q_BLOCK
    qb = qf.reshape(bsz, n_blk, Q_BLOCK, N_KV_HEADS, Q_PER_KV, HEAD_DIM).transpose(1, 0, 2, 3, 4, 5)

    def block(q_blk):
        s = jnp.einsum("bqkgd,bskd->bkgqs", q_blk, kf)
        p = jax.nn.softmax(s, axis=-1)
        return jnp.einsum("bkgqs,bskd->bqkgd", p, vf)

    o = lax.map(block, qb)
    o = o.transpose(1, 0, 2, 3, 4, 5).reshape(bsz, seq, ATTN_WIDTH)
    return o.astype(q.dtype)


def rglru_mixer(z, conv_w, conv_b, ra_w, ra_b, ix_w, ix_b, lam):
    bsz, seq, _ = z.shape
    f32 = jnp.float32
    zf = z.astype(f32)
    gate, xr = zf[..., :LRU_WIDTH], zf[..., LRU_WIDTH:]
    xc = lax.conv_general_dilated(
        xr, conv_w.astype(f32)[:, None, :], window_strides=(1,),
        padding=[(CONV_LEFT, CONV_WIDTH - 1 - CONV_LEFT)],
        dimension_numbers=("NWC", "WIO", "NWC"),
        feature_group_count=LRU_WIDTH) + conv_b.astype(f32)
    xb = xc.reshape(bsz, seq, LRU_HEADS, LRU_BLOCK)
    hs = []
    for direction in range(2):
        r = jax.nn.sigmoid(jnp.einsum("bshi,hij->bshj", xb, ra_w[direction].astype(f32)).reshape(bsz, seq, LRU_WIDTH)
                           + ra_b[direction].astype(f32))
        i = jax.nn.sigmoid(jnp.einsum("bshi,hij->bshj", xb, ix_w[direction].astype(f32)).reshape(bsz, seq, LRU_WIDTH)
                           + ix_b[direction].astype(f32))
        log_a = -LRU_C * r * jax.nn.softplus(-lam[direction].astype(f32))
        a = jnp.exp(log_a)
        b = jnp.sqrt(-jnp.expm1(2.0 * log_a)) * (i * xc)
        _, h = lax.associative_scan(_linear_combine, (a, b), reverse=(direction == 1), axis=1)
        hs.append(h)
    y = hs[0] + hs[1]
    return (y * jax.nn.gelu(gate)).astype(z.dtype)


def setup_inputs(seed: int = 0) -> dict:
    key = jax.random.key(seed)
    keys = iter(jax.random.split(key, 48))

    def normal(shape, std):
        return std * jax.random.normal(next(keys), shape, jnp.float32)

    def uniform(shape, lo, hi):
        return jax.random.uniform(next(keys), shape, jnp.float32, lo, hi)

    D = D_MODEL
    x = normal((BATCH, SEQ, D), 1.0)
    c = normal((BATCH, D), 1.0)
    norm_w = 1.0 + normal((DEPTH, 2, D), 0.02)
    ada_w = normal((DEPTH, D, 6 * D), 0.1 * D ** -0.5)
    gate_offset = jnp.tile(jnp.repeat(jnp.array([0.0, 0.0, 1.0], jnp.float32), D), 2)
    ada_b = normal((DEPTH, 6 * D), 0.02) + gate_offset
    mlp_w1 = normal((DEPTH, D, D_FF), D ** -0.5)
    mlp_w2 = normal((DEPTH, D_FF, D), D_FF ** -0.5)
    final_norm_w = 1.0 + normal((D,), 0.02)

    hyb_w_in = normal((N_EVEN, D, HYB_IN), D ** -0.5)
    s5_lam_re = -0.5 + normal((N_EVEN, 2, S5_GROUPS, S5_STATE), 0.01)
    s5_lam_im = jnp.pi * jnp.arange(S5_STATE, dtype=jnp.float32) + normal((N_EVEN, 2, S5_GROUPS, S5_STATE), 0.01)
    s5_log_dt = uniform((N_EVEN, 2, S5_GROUPS), math.log(1e-3), math.log(1e-1))
    s5_b_re = normal((N_EVEN, 2, S5_GROUPS, S5_STATE, S5_GROUP), (2 * S5_GROUP) ** -0.5)
    s5_b_im = normal((N_EVEN, 2, S5_GROUPS, S5_STATE, S5_GROUP), (2 * S5_GROUP) ** -0.5)
    s5_c_re = normal((N_EVEN, 2, S5_GROUPS, S5_GROUP, S5_STATE), S5_STATE ** -0.5)
    s5_c_im = normal((N_EVEN, 2, S5_GROUPS, S5_GROUP, S5_STATE), S5_STATE ** -0.5)
    s5_d = normal((N_EVEN, S5_WIDTH), 1.0)
    s5_glu_w = normal((N_EVEN, S5_WIDTH, S5_WIDTH), S5_WIDTH ** -0.5)
    s5_glu_b = normal((N_EVEN, S5_WIDTH), 0.01)
    attn_q_norm = 1.0 + normal((N_EVEN, HEAD_DIM), 0.02)
    attn_k_norm = 1.0 + normal((N_EVEN, HEAD_DIM), 0.02)
    hyb_w_out = normal((N_EVEN, HYB_OUT, D), HYB_OUT ** -0.5)

    rec_w_in = normal((N_ODD, D, 2 * LRU_WIDTH), D ** -0.5)
    rec_conv_w = normal((N_ODD, CONV_WIDTH, LRU_WIDTH), CONV_WIDTH ** -0.5)
    rec_conv_b = normal((N_ODD, LRU_WIDTH), 0.01)
    rec_ra_w = normal((N_ODD, 2, LRU_HEADS, LRU_BLOCK, LRU_BLOCK), LRU_BLOCK ** -0.5)
    rec_ra_b = normal((N_ODD, 2, LRU_WIDTH), 0.01)
    rec_ix_w = normal((N_ODD, 2, LRU_HEADS, LRU_BLOCK, LRU_BLOCK), LRU_BLOCK ** -0.5)
    rec_ix_b = normal((N_ODD, 2, LRU_WIDTH), 0.01)
    a_c = uniform((N_ODD, 2, LRU_WIDTH), 0.9, 0.999)
    s = a_c ** (1.0 / LRU_C)
    rec_lam = jnp.log(s) - jnp.log1p(-s)
    rec_w_out = normal((N_ODD, LRU_WIDTH, D), LRU_WIDTH ** -0.5)

    return {"x": x, "c": c, "norm_w": norm_w, "ada_w": ada_w, "ada_b": ada_b,
            "mlp_w1": mlp_w1, "mlp_w2": mlp_w2, "final_norm_w": final_norm_w,
            "hyb_w_in": hyb_w_in, "s5_lam_re": s5_lam_re, "s5_lam_im": s5_lam_im,
            "s5_log_dt": s5_log_dt, "s5_b_re": s5_b_re, "s5_b_im": s5_b_im,
            "s5_c_re": s5_c_re, "s5_c_im": s5_c_im, "s5_d": s5_d,
            "s5_glu_w": s5_glu_w, "s5_glu_b": s5_glu_b,
            "attn_q_norm": attn_q_norm, "attn_k_norm": attn_k_norm, "hyb_w_out": hyb_w_out,
            "rec_w_in": rec_w_in, "rec_conv_w": rec_conv_w, "rec_conv_b": rec_conv_b,
            "rec_ra_w": rec_ra_w, "rec_ra_b": rec_ra_b, "rec_ix_w": rec_ix_w,
            "rec_ix_b": rec_ix_b, "rec_lam": rec_lam, "rec_w_out": rec_w_out}


def reference(x, c, norm_w, ada_w, ada_b, mlp_w1, mlp_w2, final_norm_w,
              hyb_w_in, s5_lam_re, s5_lam_im, s5_log_dt, s5_b_re, s5_b_im,
              s5_c_re, s5_c_im, s5_d, s5_glu_w, s5_glu_b,
              attn_q_norm, attn_k_norm, hyb_w_out,
              rec_w_in, rec_conv_w, rec_conv_b, rec_ra_w, rec_ra_b, rec_ix_w,
              rec_ix_b, rec_lam, rec_w_out):
    seq = x.shape[1]
    cos, sin = axial_rope_tables(seq)
    c_act = jax.nn.silu(c)
    h = x
    for layer in range(DEPTH):
        mod = (c_act @ ada_w[layer] + ada_b[layer])[:, None, :]
        sh1, sc1, g1, sh2, sc2, g2 = jnp.split(mod, 6, axis=-1)
        u = rms_norm(h, norm_w[layer, 0]) * (1.0 + sc1) + sh1
        if layer % 2 == 0:
            e = layer // 2
            z = u @ hyb_w_in[e]
            z_s5 = z[..., :S5_WIDTH]
            z_q = z[..., S5_WIDTH:S5_WIDTH + ATTN_WIDTH]
            z_k = z[..., S5_WIDTH + ATTN_WIDTH:S5_WIDTH + ATTN_WIDTH + KV_WIDTH]
            z_v = z[..., S5_WIDTH + ATTN_WIDTH + KV_WIDTH:]
            y_s5 = s5_mixer(z_s5, s5_lam_re[e], s5_lam_im[e], s5_log_dt[e], s5_b_re[e], s5_b_im[e],
                            s5_c_re[e], s5_c_im[e], s5_d[e], s5_glu_w[e], s5_glu_b[e])
            y_att = axial_gqa(z_q, z_k, z_v, attn_q_norm[e], attn_k_norm[e], cos, sin)
            mix = jnp.concatenate([y_s5, y_att], axis=-1) @ hyb_w_out[e]
        else:
            o = layer // 2
            z = u @ rec_w_in[o]
            mix = rglru_mixer(z, rec_conv_w[o], rec_conv_b[o], rec_ra_w[o], rec_ra_b[o],
                              rec_ix_w[o], rec_ix_b[o], rec_lam[o]) @ rec_w_out[o]
        h = h + g1 * mix
        u = rms_norm(h, norm_w[layer, 1]) * (1.0 + sc2) + sh2
        ff = jnp.square(jax.nn.relu(u @ mlp_w1[layer])) @ mlp_w2[layer]
        h = h + g2 * ff
    return rms_norm(h, final_norm_w)
```

```cpp
#include <hip/hip_runtime.h>
#include <hip/hip_bf16.h>
#include <hip/hip_cooperative_groups.h>
#include <cstdio>
#include <cstdint>
#include <cmath>
namespace cg = cooperative_groups;
__device__ __forceinline__ int otid() { int t = threadIdx.x; asm volatile("" : "+v"(t)); return t; }
__device__ __forceinline__ float shx(float v, int mask, int lane) { return __builtin_bit_cast(float, __builtin_amdgcn_ds_bpermute((lane ^ mask) << 2, __builtin_bit_cast(int, v))); }
namespace pg8 {
#define PG8_LAS __attribute__((address_space(3)))
typedef unsigned short bf16_t;
typedef short bf16x8 __attribute__((ext_vector_type(8)));
typedef float f32x4 __attribute__((ext_vector_type(4)));
typedef unsigned u32x4 __attribute__((ext_vector_type(4)));
constexpr int BM = 256, BK = 64, HALF = 128, HTB = HALF * BK * 2  , STAGE_BYTES = 8 * HTB, NXCD = 8, WGM = 8;

__host__ __device__ __forceinline__ int lds_byte(int r, int c) { const int st = (r >> 4) * 2 + (c >> 5), rr = r & 15, cc = c & 31, ob = rr * 64 + cc * 2; return st * 1024 + (ob ^ (((ob >> 9) & 1) << 5)); }
__host__ __device__ __forceinline__ void stage_rc(int b, int& R, int& C) { const int st = b / 1024, sb = b % 1024, swz = sb ^ (((sb >> 9) & 1) << 5); R = (st >> 1) * 16 + swz / 64; C = (st & 1) * 32 + (swz % 64) / 2; }
__host__ __device__ __forceinline__ int perm32(int rho) { const int n = rho >> 4, i = rho & 15; return 8 * (i >> 2) + 4 * n + (i & 3); }

struct Unit { int pm, pn; };
typedef unsigned u32x2 __attribute__((ext_vector_type(2)));
}
namespace pg8 {
struct Gemm { const bf16_t* A; const bf16_t* Bt; int lda, ldb, K, perm; };
__device__ __forceinline__ unsigned cvt_pk_bf16(float lo, float hi) { unsigned r; asm volatile("v_cvt_pk_bf16_f32 %0, %1, %2" : "=v"(r) : "v"(lo), "v"(hi)); return r; }
__device__ __forceinline__ float bflo(unsigned w) { return __uint_as_float(w << 16); }
__device__ __forceinline__ float bfhi(unsigned w) { return __uint_as_float(w & 0xffff0000u); }
__device__ __forceinline__ float gelu_tanh(float x) { const float z = 0.7978845608028654f * (x + 0.044715f * x * x * x); return x / (1.0f + __expf(-2.0f * z)); }
__device__ __forceinline__ float sigmoidf_(float x) { return 1.0f / (1.0f + __expf(-x)); }

struct Sched { int mode, nM, nN, nwg, G, c;
    __device__ __forceinline__ bool next(int i, Unit& u) const {
        const long L = (long)i * G + c; if (L >= nwg) return false;
        if (mode == 0) {
            int wgid = (int)L; { const int q = nwg / NXCD, r = nwg % NXCD, xcd = wgid % NXCD, off = wgid / NXCD; wgid = (xcd < r ? xcd * (q + 1) : r * (q + 1) + (xcd - r) * q) + off; }
            const int nig = WGM * nN, gid = wgid / nig, fm = gid * WGM, gsz = (nM - fm) < WGM ? (nM - fm) : WGM;
            u.pm = fm + ((wgid % nig) % gsz); u.pn = (wgid % nig) / gsz;
        } else if (mode == 1) { u.pm = (int)L; u.pn = (int)L >> 2; }
        else { u.pm = (int)L >> 1; u.pn = (((int)L >> 3) << 1) + ((int)L & 1); }
        return true;
    }
    __device__ __forceinline__ void a_ready(const Unit&) const {}
    __device__ __forceinline__ void done(const Unit&) const {}
};

enum { EM_INA = 0, EM_INB = 1, EM_MLP1 = 2, EM_S5E = 3, EM_S5Y = 4, EM_GLU = 5, EM_RES = 6 };
struct Epi {
    static constexpr bool AFTER_DRAIN = false;
    int mode; const PG8_LAS unsigned long long* d;
    __device__ __forceinline__ unsigned long long P(int i) const { const unsigned long long v = d[i]; const unsigned lo = __builtin_amdgcn_readfirstlane((unsigned)v), hi = __builtin_amdgcn_readfirstlane((unsigned)(v >> 32)); return ((unsigned long long)hi << 32) | lo; }
    __device__ __forceinline__ void operator()(const f32x4 (&acc)[2][2][4][2], const Unit& u, int wr, int wc, int fr, int fq) const {
        if (mode <= EM_MLP1) {
            const float* rowss = (const float*)P(0); const float* shw = (const float*)P(1); const int ldshw = (int)P(14); bf16_t* o0 = (bf16_t*)P(2); bf16_t* o1 = (bf16_t*)P(3); bf16_t* o2 = (bf16_t*)P(4); bf16_t* o3 = (bf16_t*)P(5);
            const int bb = u.pm >> 4;
            const int colt = u.pn * BM + wc * 32 + 8 * fq;
            f32x4 sv[2][2];
#pragma unroll
            for (int bj = 0; bj < 2; ++bj)
#pragma unroll
                for (int n = 0; n < 2; ++n) sv[bj][n] = *(const f32x4*)(shw + (size_t)bb * ldshw + colt + bj * HALF + 4 * n);
#pragma unroll
            for (int ai = 0; ai < 2; ++ai)
#pragma unroll
                for (int m = 0; m < 4; ++m) {
                    const int row = u.pm * BM + ai * HALF + wr * 64 + m * 16 + fr;
                    const f32x4* rs = (const f32x4*)(rowss + (size_t)row * 16);
                    const f32x4 ra = rs[0], rb = rs[1], rc = rs[2], rd = rs[3];
                    const float ss = ((ra[0] + ra[1]) + (ra[2] + ra[3])) + ((rb[0] + rb[1]) + (rb[2] + rb[3])) + ((rc[0] + rc[1]) + (rc[2] + rc[3])) + ((rd[0] + rd[1]) + (rd[2] + rd[3]));
                    const float rstd = 1.0f / sqrtf(ss * (1.0f / 1024.0f) + 1e-6f);
#pragma unroll
                    for (int bj = 0; bj < 2; ++bj) {
                        f32x4 v0 = acc[ai][bj][m][0] * rstd + sv[bj][0], v1 = acc[ai][bj][m][1] * rstd + sv[bj][1];
                        const int col = colt + bj * HALF;
                        bf16_t* dst;
                        if (mode == EM_MLP1) {
#pragma unroll
                            for (int j = 0; j < 4; ++j) { const float a = fmaxf(v0[j], 0.f), b = fmaxf(v1[j], 0.f); v0[j] = a * a; v1[j] = b * b; }
                            dst = o0 + (size_t)row * 4096 + col;
                        } else if (mode == EM_INB) { dst = o0 + (size_t)row * 2048 + col; }
                        else {
                            if (u.pn < 2) { const int g = col >> 4, c0 = col & 15, s = row & 4095; dst = o0 + ((size_t)(g * 1024 + bb * 128 + (s >> 5)) * 768 + (s & 31) * 16 + c0); }
                            else if (u.pn < 4) dst = o1 + (size_t)row * 512 + (col - 512);
                            else if (bj == 0) dst = o2 + (size_t)row * 128 + (col - 1024);
                            else dst = o3 + (size_t)row * 128 + (col - 1152);
                        }
                        u32x4 w; w.x = cvt_pk_bf16(v0[0], v0[1]); w.y = cvt_pk_bf16(v0[2], v0[3]); w.z = cvt_pk_bf16(v1[0], v1[1]); w.w = cvt_pk_bf16(v1[2], v1[3]);
                        *(u32x4*)dst = w;
                    }
                }
        } else if (mode == EM_S5E) {
            float* of = (float*)P(6);
#pragma unroll
            for (int ai = 0; ai < 2; ++ai)
#pragma unroll
                for (int m = 0; m < 4; ++m) {
                    const int row = u.pm * BM + ai * HALF + wr * 64 + m * 16 + fr;
#pragma unroll
                    for (int bj = 0; bj < 2; ++bj)
#pragma unroll
                        for (int n = 0; n < 2; ++n) *(f32x4*)(of + (size_t)row * 256 + bj * HALF + wc * 32 + n * 16 + 4 * fq) = acc[ai][bj][m][n];
                }
        } else if (mode == EM_S5Y) {
            const float* vec = (const float*)P(12); const bf16_t* gin = (const bf16_t*)P(13); bf16_t* o0 = (bf16_t*)P(2);
            const int g = u.pn >> 1, pnl = u.pn & 1;
            const int c0 = 8 * (fq & 1);
            const f32x4 d0 = *(const f32x4*)(vec + g * 16 + c0), d1 = *(const f32x4*)(vec + g * 16 + c0 + 4);
#pragma unroll
            for (int ai = 0; ai < 2; ++ai)
#pragma unroll
                for (int m = 0; m < 4; ++m) {
                    const int row = u.pm * BM + ai * HALF + wr * 64 + m * 16 + fr;
                    const int rg = row & 1023, b = rg >> 7, k = rg & 127;
#pragma unroll
                    for (int bj = 0; bj < 2; ++bj) {
                        const int nn = pnl * BM + bj * HALF + wc * 32 + 8 * fq, tl = nn >> 4;
                        const u32x4 uu = *(const u32x4*)(gin + (size_t)row * 768 + tl * 16 + c0);
                        f32x4 v0 = acc[ai][bj][m][0], v1 = acc[ai][bj][m][1];
                        v0[0] += d0[0] * bflo(uu.x); v0[1] += d0[1] * bfhi(uu.x); v0[2] += d0[2] * bflo(uu.y); v0[3] += d0[3] * bfhi(uu.y);
                        v1[0] += d1[0] * bflo(uu.z); v1[1] += d1[1] * bfhi(uu.z); v1[2] += d1[2] * bflo(uu.w); v1[3] += d1[3] * bfhi(uu.w);
#pragma unroll
                        for (int j = 0; j < 4; ++j) { v0[j] = gelu_tanh(v0[j]); v1[j] = gelu_tanh(v1[j]); }
                        u32x4 w; w.x = cvt_pk_bf16(v0[0], v0[1]); w.y = cvt_pk_bf16(v0[2], v0[3]); w.z = cvt_pk_bf16(v1[0], v1[1]); w.w = cvt_pk_bf16(v1[2], v1[3]);
                        const size_t token = (size_t)b * 4096 + k * 32 + tl;
                        *(u32x4*)(o0 + token * 512 + g * 16 + c0) = w;
                    }
                }
        } else if (mode == EM_GLU) {
            const float* vec = (const float*)P(12); const bf16_t* gin = (const bf16_t*)P(13); bf16_t* o0 = (bf16_t*)P(2);
            const int colt = u.pn * BM + wc * 32 + 8 * fq;
            f32x4 bv[2][2];
#pragma unroll
            for (int bj = 0; bj < 2; ++bj)
#pragma unroll
                for (int n = 0; n < 2; ++n) bv[bj][n] = *(const f32x4*)(vec + colt + bj * HALF + 4 * n);
#pragma unroll
            for (int ai = 0; ai < 2; ++ai)
#pragma unroll
                for (int m = 0; m < 4; ++m) {
                    const int row = u.pm * BM + ai * HALF + wr * 64 + m * 16 + fr;
#pragma unroll
                    for (int bj = 0; bj < 2; ++bj) {
                        const int col = colt + bj * HALF;
                        const u32x4 gg = *(const u32x4*)(gin + (size_t)row * 512 + col);
                        f32x4 v0 = acc[ai][bj][m][0] + bv[bj][0], v1 = acc[ai][bj][m][1] + bv[bj][1];
                        v0[0] = bflo(gg.x) * sigmoidf_(v0[0]); v0[1] = bfhi(gg.x) * sigmoidf_(v0[1]); v0[2] = bflo(gg.y) * sigmoidf_(v0[2]); v0[3] = bfhi(gg.y) * sigmoidf_(v0[3]);
                        v1[0] = bflo(gg.z) * sigmoidf_(v1[0]); v1[1] = bfhi(gg.z) * sigmoidf_(v1[1]); v1[2] = bflo(gg.w) * sigmoidf_(v1[2]); v1[3] = bfhi(gg.w) * sigmoidf_(v1[3]);
                        u32x4 w; w.x = cvt_pk_bf16(v0[0], v0[1]); w.y = cvt_pk_bf16(v0[2], v0[3]); w.z = cvt_pk_bf16(v1[0], v1[1]); w.w = cvt_pk_bf16(v1[2], v1[3]);
                        *(u32x4*)(o0 + (size_t)row * 1024 + col) = w;
                    }
                }
        } else {
            float* of = (float*)P(6); const float* hin = (const float*)P(7); const float* gate = (const float*)P(8); const float* nw = (const float*)P(9); const float* nsc = (const float*)P(10); float* rowss_out = (float*)P(11); bf16_t* o0 = (bf16_t*)P(2);
            const int bb = u.pm >> 4;
            const int colt = u.pn * BM + wc * 32 + 4 * fq;
            f32x4 gv[2][2], wv[2][2];
#pragma unroll
            for (int bj = 0; bj < 2; ++bj)
#pragma unroll
                for (int n = 0; n < 2; ++n) { const int col = colt + bj * HALF + n * 16;
                    gv[bj][n] = *(const f32x4*)(gate + (size_t)bb * 6144 + col);
                    if (nw) { const f32x4 a = *(const f32x4*)(nw + col), s = *(const f32x4*)(nsc + (size_t)bb * 6144 + col); wv[bj][n] = a * (s + 1.0f); } else wv[bj][n] = (f32x4){0.f, 0.f, 0.f, 0.f}; }
#pragma unroll
            for (int ai = 0; ai < 2; ++ai)
#pragma unroll
                for (int m = 0; m < 4; ++m) {
                    const int row = u.pm * BM + ai * HALF + wr * 64 + m * 16 + fr;
                    float sq = 0.f;
#pragma unroll
                    for (int bj = 0; bj < 2; ++bj)
#pragma unroll
                        for (int n = 0; n < 2; ++n) { const size_t off = (size_t)row * 1024 + colt + bj * HALF + n * 16;
                            const f32x4 h0 = *(const f32x4*)(hin + off);
                            const f32x4 h = h0 + gv[bj][n] * acc[ai][bj][m][n];
                            *(f32x4*)(of + off) = h;
                            sq += (h[0] * h[0] + h[1] * h[1]) + (h[2] * h[2] + h[3] * h[3]);
                            if (nw) { const f32x4 hw = h * wv[bj][n]; u32x2 w; w.x = cvt_pk_bf16(hw[0], hw[1]); w.y = cvt_pk_bf16(hw[2], hw[3]); *(u32x2*)(o0 + off) = w; } }
                    sq += shx(sq, 16, fr + 16 * fq); sq += shx(sq, 32, fr + 16 * fq);
                    if (fq == 0) rowss_out[(size_t)row * 16 + u.pn * 4 + wc] = sq;
                }
        }
    }
};
}
namespace pg8 {
template <class Epi, class Sched, bool ALIGN_EPI = false, bool SP2 = false>
__device__ __forceinline__ void gemm_phase(PG8_LAS unsigned char* lds, const Gemm g, const Sched& S, const Epi& E) {
    const int tid = otid(), wid = __builtin_amdgcn_readfirstlane(tid >> 6), lane = tid & 63, wr = wid >> 2, wc = wid & 3, fr = lane & 15, fq = lane >> 4;
    const int K = g.K, nt = K / BK;
    unsigned voffA[2], voffB[2];
#pragma unroll
    for (int i = 0; i < 2; ++i) { int R, C; stage_rc(tid * 16 + i * 8192, R, C); const int Rb = g.perm ? ((R & ~31) + perm32(R & 31)) : R;
        voffA[i] = (unsigned)(R * g.lda + C) * 2u; voffB[i] = (unsigned)(Rb * g.ldb + C) * 2u; }
    const size_t kstep = (size_t)(BK * 2);
    const size_t hstepA = (size_t)HALF * g.lda * 2, hstepB = (size_t)HALF * g.ldb * 2;
    const size_t tstepA = 2 * hstepA, tstepB = 2 * hstepB;
    const unsigned ldsw = (unsigned)wid * 1024u;
    const int aoff = lds_byte(wr * 64 + fr, fq * 8), boff = lds_byte(wc * 32 + fr, fq * 8);
#define PG8_SA(b, h) (((b) * 2 + (h)) * HTB)
#define PG8_SB(b, h) ((4 + (b) * 2 + (h)) * HTB)
#define PG8_STAGE(bufoff, gbase, voff) do { _Pragma("unroll") for (int _i = 0; _i < 2; ++_i) \
        __builtin_amdgcn_global_load_lds((const unsigned*)((const char*)(gbase) + (voff)[_i]), (PG8_LAS unsigned*)(lds + (bufoff) + ldsw + _i * 8192), 16, 0, 0); } while (0)
#define PG8_LDA(dst, b, h) do { _Pragma("unroll") for (int m = 0; m < 4; ++m) _Pragma("unroll") for (int k = 0; k < 2; ++k) dst[m][k] = *(const PG8_LAS bf16x8*)(lds + PG8_SA(b, h) + aoff + m * 2048 + k * 1024); } while (0)
#define PG8_LDB(dst, b, h) do { _Pragma("unroll") for (int n = 0; n < 2; ++n) _Pragma("unroll") for (int k = 0; k < 2; ++k) dst[n][k] = *(const PG8_LAS bf16x8*)(lds + PG8_SB(b, h) + boff + n * 2048 + k * 1024); } while (0)
#define PG8_MMA(ai, bj, At, Bt) do { __builtin_amdgcn_s_setprio(1); _Pragma("unroll") for (int m = 0; m < 4; ++m) _Pragma("unroll") for (int n = 0; n < 2; ++n) _Pragma("unroll") for (int k = 0; k < 2; ++k) \
        acc[ai][bj][m][n] = __builtin_amdgcn_mfma_f32_16x16x32_bf16(Bt[n][k], At[m][k], acc[ai][bj][m][n], 0, 0, 0); __builtin_amdgcn_s_setprio(0); } while (0)
#define PG8_WAIT_V(n) asm volatile("s_waitcnt vmcnt(" #n ")" ::: "memory")
#define PG8_WAIT_L(n) asm volatile("s_waitcnt lgkmcnt(" #n ")" ::: "memory")
#define PG8_BAR __builtin_amdgcn_s_barrier()
#define PG8_SCHED __builtin_amdgcn_sched_barrier(0)
    Unit cur, nxt; int ui = 0;
    if (!S.next(0, cur)) return;
    f32x4 acc[2][2][4][2];
#pragma unroll
    for (int a = 0; a < 2; ++a)
#pragma unroll
        for (int b = 0; b < 2; ++b)
#pragma unroll
            for (int m = 0; m < 4; ++m)
#pragma unroll
                for (int n = 0; n < 2; ++n) acc[a][b][m][n] = (f32x4){0.f, 0.f, 0.f, 0.f};
    bf16x8 At[4][2], B0[2][2], B1[2][2];
    const char* cA = (const char*)g.A + (size_t)cur.pm * tstepA; const char* cB = (const char*)g.Bt + (size_t)cur.pn * tstepB;
    S.a_ready(cur);
    if constexpr (SP2) {
        PG8_STAGE(PG8_SB(0, 0), cB, voffB); PG8_STAGE(PG8_SB(0, 1), cB + hstepB, voffB); PG8_STAGE(PG8_SA(0, 0), cA, voffA); PG8_STAGE(PG8_SA(0, 1), cA + hstepA, voffA);
        if (wr == 1) PG8_BAR;
        PG8_WAIT_V(2); PG8_BAR;
        PG8_STAGE(PG8_SB(1, 0), cB + kstep, voffB); PG8_STAGE(PG8_SA(1, 0), cA + kstep, voffA); PG8_STAGE(PG8_SB(1, 1), cB + hstepB + kstep, voffB);
        PG8_WAIT_V(6); PG8_BAR;
    } else {
        PG8_STAGE(PG8_SB(0, 0), cB, voffB); PG8_STAGE(PG8_SA(0, 0), cA, voffA); PG8_STAGE(PG8_SB(0, 1), cB + hstepB, voffB); PG8_STAGE(PG8_SA(0, 1), cA + hstepA, voffA);
        if (wr == 1) PG8_BAR;
        PG8_WAIT_V(4); PG8_BAR;
        PG8_STAGE(PG8_SB(1, 0), cB + kstep, voffB); PG8_STAGE(PG8_SA(1, 0), cA + kstep, voffA); PG8_STAGE(PG8_SB(1, 1), cB + hstepB + kstep, voffB);
        PG8_WAIT_V(6); PG8_BAR;
    }
    for (;;) {
        const bool has_next = S.next(ui + 1, nxt);
        const char* nA = has_next ? (const char*)g.A + (size_t)nxt.pm * tstepA : cA; const char* nB = has_next ? (const char*)g.Bt + (size_t)nxt.pn * tstepB : cB;
        for (int t = 0; t < nt; t += 2) {
            const bool last = (t == nt - 2);
            const char* a1 = cA + (size_t)(t + 1) * kstep;
            const char* a2 = last ? nA : cA + (size_t)(t + 2) * kstep; const char* b2 = last ? nB : cB + (size_t)(t + 2) * kstep;
            const char* a3 = a2 + kstep; const char* b3 = b2 + kstep;
            if (last && has_next) S.a_ready(nxt);
            if constexpr (SP2) {
            PG8_LDB(B0, 0, 0); PG8_LDB(B1, 0, 1); PG8_SCHED; PG8_LDA(At, 0, 0); PG8_STAGE(PG8_SA(1, 1), a1 + hstepA, voffA);
            PG8_WAIT_V(8); PG8_WAIT_L(0); PG8_BAR; PG8_MMA(0, 0, At, B0); PG8_MMA(0, 1, At, B1); PG8_BAR; PG8_SCHED;
            PG8_LDA(At, 0, 1); PG8_STAGE(PG8_SB(0, 0), b2, voffB); PG8_STAGE(PG8_SB(0, 1), b2 + hstepB, voffB); PG8_STAGE(PG8_SA(0, 0), a2, voffA);
            PG8_WAIT_V(8); PG8_WAIT_L(0); PG8_BAR; PG8_MMA(1, 0, At, B0); PG8_MMA(1, 1, At, B1); PG8_BAR; PG8_SCHED;
            PG8_LDB(B0, 1, 0); PG8_LDB(B1, 1, 1); PG8_SCHED; PG8_LDA(At, 1, 0); PG8_STAGE(PG8_SA(0, 1), a2 + hstepA, voffA);
            PG8_WAIT_V(8); PG8_WAIT_L(0); PG8_BAR; PG8_MMA(0, 0, At, B0); PG8_MMA(0, 1, At, B1); PG8_BAR; PG8_SCHED;
            PG8_LDA(At, 1, 1); PG8_STAGE(PG8_SB(1, 0), b3, voffB); PG8_STAGE(PG8_SB(1, 1), b3 + hstepB, voffB); PG8_STAGE(PG8_SA(1, 0), a3, voffA);
            PG8_WAIT_V(8); PG8_WAIT_L(0); PG8_BAR; PG8_MMA(1, 0, At, B0); PG8_MMA(1, 1, At, B1); PG8_BAR; PG8_SCHED;
            } else {
            PG8_LDB(B0, 0, 0); PG8_SCHED; PG8_LDA(At, 0, 0); PG8_STAGE(PG8_SA(1, 1), a1 + hstepA, voffA);
            PG8_WAIT_L(8); PG8_BAR; PG8_WAIT_L(0); PG8_MMA(0, 0, At, B0); PG8_BAR; PG8_SCHED;
            PG8_LDB(B1, 0, 1); PG8_STAGE(PG8_SB(0, 0), b2, voffB);
            PG8_BAR; PG8_WAIT_L(0); PG8_MMA(0, 1, At, B1); PG8_BAR;
            PG8_LDA(At, 0, 1); PG8_STAGE(PG8_SA(0, 0), a2, voffA);
            PG8_BAR; PG8_WAIT_L(0); PG8_MMA(1, 0, At, B0); PG8_BAR; PG8_SCHED;
            PG8_STAGE(PG8_SB(0, 1), b2 + hstepB, voffB);
            PG8_WAIT_V(6); PG8_BAR; PG8_MMA(1, 1, At, B1); PG8_BAR;
            PG8_LDB(B0, 1, 0); PG8_SCHED; PG8_LDA(At, 1, 0); PG8_STAGE(PG8_SA(0, 1), a2 + hstepA, voffA);
            PG8_WAIT_L(8); PG8_BAR; PG8_WAIT_L(0); PG8_MMA(0, 0, At, B0); PG8_BAR; PG8_SCHED;
            PG8_LDB(B1, 1, 1); PG8_STAGE(PG8_SB(1, 0), b3, voffB);
            PG8_BAR; PG8_WAIT_L(0); PG8_MMA(0, 1, At, B1); PG8_BAR;
            PG8_LDA(At, 1, 1); PG8_STAGE(PG8_SA(1, 0), a3, voffA);
            PG8_BAR; PG8_WAIT_L(0); PG8_MMA(1, 0, At, B0); PG8_BAR; PG8_SCHED;
            PG8_STAGE(PG8_SB(1, 1), b3 + hstepB, voffB);
            PG8_WAIT_V(6); PG8_BAR; PG8_MMA(1, 1, At, B1); PG8_BAR;
            }
        }
        if constexpr (ALIGN_EPI) { if (wr == 0) PG8_BAR; }
        if constexpr (!Epi::AFTER_DRAIN) { E(acc, cur, wr, wc, fr, fq); S.done(cur); }
        if (!has_next) break;
#pragma unroll
        for (int a = 0; a < 2; ++a)
#pragma unroll
            for (int b = 0; b < 2; ++b)
#pragma unroll
                for (int m = 0; m < 4; ++m)
#pragma unroll
                    for (int n = 0; n < 2; ++n) acc[a][b][m][n] = (f32x4){0.f, 0.f, 0.f, 0.f};
        cur = nxt; cA = nA; cB = nB; ++ui;
        if constexpr (ALIGN_EPI) { if (wr == 1) PG8_BAR; }
    }
    PG8_WAIT_V(0);
    if constexpr (!ALIGN_EPI) { if (wr == 0) PG8_BAR; }
    PG8_BAR;
    if constexpr (Epi::AFTER_DRAIN) { E.fused(acc, cur, wr, wc, fr, fq, lds, wid, lane); S.done(cur); }
#undef PG8_SA
#undef PG8_SB
#undef PG8_STAGE
#undef PG8_LDA
#undef PG8_LDB
#undef PG8_MMA
#undef PG8_WAIT_V
#undef PG8_WAIT_L
#undef PG8_BAR
#undef PG8_SCHED
}
}
#include <hip/hip_bf16.h>
#include <cmath>
namespace attn_body {
using bf16=__hip_bfloat16;
using bf16x8=__attribute__((ext_vector_type(8)))short;
using s16x4=__attribute__((ext_vector_type(4)))short;
using f32x16=__attribute__((ext_vector_type(16)))float;
using u32x4=__attribute__((ext_vector_type(4)))unsigned;
constexpr int BATCH=8,NHEAD=8,SEQ=4096,D=64,QP=512,KP=128,OP=1024;
constexpr int NW=8,QBLK=32,QB=QBLK*NW,KVBLK=64,NQB=SEQ/QB;
constexpr int ATTN_UNIT_ROWS=QB;
__device__ __forceinline__ int crow(int r,int hi){return (r&3)+8*(r>>2)+4*hi;}
#define SBAR() __builtin_amdgcn_sched_barrier(0)
__device__ __forceinline__ void cmask(f32x16&p0,f32x16&p1,int jb,int qrel,int hi){
  const float NEG=-INFINITY; int kb=64*jb+4*hi;
  #pragma unroll
  for(int r=0;r<16;++r){int kv=kb+(r&3)+8*(r>>2); if(kv>qrel)p0[r]=NEG; if(kv+32>qrel)p1[r]=NEG;}
}

constexpr int NSLOT=3, SLOTB=8192;
constexpr int LDS_K=0, LDS_V=NSLOT*SLOTB, LDS_WS=2*NSLOT*SLOTB, LDS_OST=LDS_WS+NW*64*4, LDS_BYTES=LDS_OST+NW*4096;
constexpr float C2=0.125f*1.4426950408889634f;
__device__ __forceinline__ void glds16(const void*gsrc,unsigned lds_dst){unsigned keep;
  asm volatile("s_mov_b32 %0, m0\n\ts_mov_b32 m0, %2\n\ts_nop 0\n\tglobal_load_lds_dwordx4 %1, off\n\ts_mov_b32 m0, %0":"=&s"(keep):"v"(gsrc),"s"(lds_dst):"memory");}
__device__ __forceinline__ float max3f(float a,float b,float c){float r;asm("v_max3_f32 %0, %1, %2, %3":"=v"(r):"v"(a),"v"(b),"v"(c));return r;}
__device__ __forceinline__ float max2f(float a,float b){float r;asm("v_max_f32_e32 %0, %1, %2":"=v"(r):"v"(a),"v"(b));return r;}
__device__ __forceinline__ float fadd_s(float a,float b){float r;asm("v_add_f32_e32 %0, %1, %2":"=v"(r):"v"(a),"v"(b));return r;}
__device__ __forceinline__ float fsub_s(float a,float b){float r;asm("v_sub_f32_e32 %0, %1, %2":"=v"(r):"v"(a),"v"(b));return r;}
typedef float f32x2_t __attribute__((ext_vector_type(2))); typedef __bf16 bf16x2_t __attribute__((ext_vector_type(2)));
__device__ __forceinline__ unsigned cvtpk_s(float lo,float hi){f32x2_t v={lo,hi};bf16x2_t b=__builtin_convertvector(v,bf16x2_t);return __builtin_bit_cast(unsigned,b);}
#define WAIT_BAR(N) asm volatile("s_waitcnt vmcnt(" #N ") lgkmcnt(0)\n\ts_barrier":::"memory")

__device__ __forceinline__ void qkt(f32x16&p0,f32x16&p1,const char*Kslot,const bf16x8*qr,const f32x16&negm,int r32,int hi){
  const char*kb=Kslot+hi*1024+r32*16;
  #pragma unroll
  for(int d0=0;d0<4;++d0){
    const bf16x8 b0=*reinterpret_cast<const bf16x8*>(kb+d0*2048);
    const bf16x8 b1=*reinterpret_cast<const bf16x8*>(kb+d0*2048+512);
    if(d0==0){p0=__builtin_amdgcn_mfma_f32_32x32x16_bf16(b0,qr[0],negm,0,0,0);p1=__builtin_amdgcn_mfma_f32_32x32x16_bf16(b1,qr[0],negm,0,0,0);}
    else{p0=__builtin_amdgcn_mfma_f32_32x32x16_bf16(b0,qr[d0],p0,0,0,0);p1=__builtin_amdgcn_mfma_f32_32x32x16_bf16(b1,qr[d0],p1,0,0,0);}}
}
typedef __attribute__((address_space(3))) const char* lds_cptr;
typedef short v4i16_t __attribute__((ext_vector_type(4)));
__device__ __forceinline__ void kload8(bf16x8*kf,lds_cptr kp){
  kf[0]=*(const __attribute__((address_space(3))) bf16x8*)(kp);      kf[1]=*(const __attribute__((address_space(3))) bf16x8*)(kp+512);
  kf[2]=*(const __attribute__((address_space(3))) bf16x8*)(kp+2048); kf[3]=*(const __attribute__((address_space(3))) bf16x8*)(kp+2560);
  kf[4]=*(const __attribute__((address_space(3))) bf16x8*)(kp+4096); kf[5]=*(const __attribute__((address_space(3))) bf16x8*)(kp+4608);
  kf[6]=*(const __attribute__((address_space(3))) bf16x8*)(kp+6144); kf[7]=*(const __attribute__((address_space(3))) bf16x8*)(kp+6656);
}
__device__ __forceinline__ void kload2(bf16x8*kf,lds_cptr kp,int j){ kf[2*j]=*(const __attribute__((address_space(3))) bf16x8*)(kp+j*2048); kf[2*j+1]=*(const __attribute__((address_space(3))) bf16x8*)(kp+j*2048+512); }
__device__ __forceinline__ s16x4 vtr(lds_cptr p){ return __builtin_bit_cast(s16x4,__builtin_amdgcn_ds_read_tr16_b64_v4i16((__attribute__((address_space(3))) v4i16_t*)p)); }
__device__ __forceinline__ float rowmax(const f32x16&p0,const f32x16&p1){
  float a=max3f(p0[0],p0[1],p1[0]),b=max3f(p0[2],p0[3],p1[1]);a=max3f(a,p1[2],p1[3]);
  #pragma unroll
  for(int r=4;r<16;r+=4){a=max3f(a,p0[r],p0[r+1]);b=max3f(b,p0[r+2],p0[r+3]);a=max3f(a,p1[r],p1[r+1]);b=max3f(b,p1[r+2],p1[r+3]);}
  const float m=max2f(a,b);
  auto rr=__builtin_amdgcn_permlane32_swap(__float_as_uint(m),__float_as_uint(m),false,false);
  return max2f(__uint_as_float(rr[0]),__uint_as_float(rr[1]));
}
__device__ __forceinline__ void pv(f32x16*o,int vb,bf16x8 pa0,bf16x8 pa1,bf16x8 pa2,bf16x8 pa3){
  #pragma unroll
  for(int d0=0;d0<2;++d0){s16x4 lo[4],hi[4];
    #pragma unroll
    for(int ks=0;ks<4;++ks){
      asm volatile("ds_read_b64_tr_b16 %0,%1 offset:%c2":"=&v"(lo[ks]):"v"(vb),"i"(d0*4096+ks*1024):"memory");
      asm volatile("ds_read_b64_tr_b16 %0,%1 offset:%c2":"=&v"(hi[ks]):"v"(vb),"i"(d0*4096+ks*1024+512):"memory");}
    asm volatile("s_waitcnt lgkmcnt(0)":::"memory");SBAR();
    #define PK(k) (bf16x8){lo[k][0],lo[k][1],lo[k][2],lo[k][3],hi[k][0],hi[k][1],hi[k][2],hi[k][3]}
    o[d0]=__builtin_amdgcn_mfma_f32_32x32x16_bf16(pa0,PK(0),o[d0],0,0,0);
    o[d0]=__builtin_amdgcn_mfma_f32_32x32x16_bf16(pa1,PK(1),o[d0],0,0,0);
    o[d0]=__builtin_amdgcn_mfma_f32_32x32x16_bf16(pa2,PK(2),o[d0],0,0,0);
    o[d0]=__builtin_amdgcn_mfma_f32_32x32x16_bf16(pa3,PK(3),o[d0],0,0,0);
    #undef PK
  }
}

#ifndef ATTN_STORE16
#define ATTN_STORE16(p,v) (*(u32x4*)(p)=(v))
#endif
template<int THRL> __device__ __forceinline__ void attn_unit(int b,int h,int qb,const bf16*Q,const bf16*__restrict__ K,const bf16*__restrict__ V,bf16*O,char*shm){
  const int tid=otid(),lane=tid&63,r32=lane&31,hi=lane>>5; const int wid=__builtin_amdgcn_readfirstlane(tid>>6);
  const long rowbase=(long)b*SEQ; const int q0=qb*QB;
  const bf16*Qw=Q+(rowbase+q0+wid*QBLK)*QP+h*D;
  const bf16*Kh=K+rowbase*KP+(h>>2)*D,*Vh=V+rowbase*KP+(h>>2)*D;
  const unsigned lds0=(unsigned)(uintptr_t)shm;
  float*wsf=(float*)(shm+LDS_WS)+wid*64;
  const bf16*ksrc=Kh+(long)lane*KP+wid*8;
  const bf16*vsrc=Vh+(long)(16*(wid&3)+(lane>>2))*KP+(wid>>2)*32+(lane&3)*8;
  const unsigned kdst=lds0+LDS_K+wid*1024, vdst=lds0+LDS_V+wid*1024;
  #define DMA_K(t,slot) glds16(ksrc+(long)(t)*KVBLK*KP,(unsigned)__builtin_amdgcn_readfirstlane(kdst+(slot)))
  #define DMA_V(t,slot) glds16(vsrc+(long)(t)*KVBLK*KP,(unsigned)__builtin_amdgcn_readfirstlane(vdst+(slot)))
  const int vb0=(int)(lds0+LDS_V)+((lane>>4)&1)*32+(lane&3)*8+(4*hi+((lane&15)>>2))*64;
  const char*Kbase=shm+LDS_K; bf16x8 kf[8];
  const lds_cptr shm3=(lds_cptr)shm; const lds_cptr kp0=shm3+LDS_K+hi*1024+r32*16; const lds_cptr vp0=shm3+LDS_V+((lane>>4)&1)*32+(lane&3)*8+(4*hi+((lane&15)>>2))*64;
  const int NT=SEQ/KVBLK;
  DMA_K(0,0);DMA_V(0,0);DMA_K(1,SLOTB);
  bf16x8 qr[4];
  #pragma unroll
  for(int d0=0;d0<4;++d0)qr[d0]=*reinterpret_cast<const bf16x8*>(&Qw[(long)r32*QP+d0*16+hi*8]);
  float mhat=0.f,l_reg=0.f;f32x16 o[2];o[0]=f32x16{};o[1]=f32x16{};f32x16 negm=f32x16{};asm volatile("":"+v"(negm));

  #define CMASK(P0,P1,t) do{}while(0)
  bool resc=false;
  #define START(P0,P1) do{ const float rm=rowmax(P0,P1); resc=false; \
    { const float dl=rm; mhat=fadd_s(mhat,dl); \
      _Pragma("unroll") for(int r=0;r<16;++r){P0[r]=fsub_s(P0[r],dl);P1[r]=fsub_s(P1[r],dl);} \
      _Pragma("unroll") for(int r=0;r<16;++r)negm[r]=-mhat; asm volatile("":"+v"(negm)); } \
    _Pragma("unroll") for(int r=0;r<16;++r)P0[r]=__builtin_amdgcn_exp2f(P0[r]); }while(0)
  #define RESC() do{ if(resc){ asm volatile("s_waitcnt lgkmcnt(0)":::"memory"); \
      _Pragma("unroll") for(int d_=0;d_<2;++d_) _Pragma("unroll") for(int r=0;r<16;++r)o[d_][r]*=wsf[crow(r,hi)]; } }while(0)
  f32x16 pA0,pA1,pB0,pB1;
  int sl_prev=0,sl_cur=0,sl_next=SLOTB;
  #define ROT() do{sl_prev=sl_cur;sl_cur=sl_next;sl_next=(sl_next==(NSLOT-1)*SLOTB)?0:sl_next+SLOTB;}while(0)
  DMA_K(2,2*SLOTB);
  WAIT_BAR(3);
  qkt(pA0,pA1,Kbase,qr,negm,r32,hi);asm volatile("s_nop 15\n\ts_nop 7":"+v"(pA0),"+v"(pA1));CMASK(pA0,pA1,0);
  START(pA0,pA1);
  _Pragma("unroll") for(int r=0;r<16;++r)pA1[r]=__builtin_amdgcn_exp2f(pA1[r]);
  WAIT_BAR(0);
  DMA_K(3,0);DMA_V(1,SLOTB);
  ROT();
  kload8(kf,kp0+sl_cur);
  WAIT_BAR(2);
  s16x4 vlo[8],vhi[8]; u32x4 pw0,pw1,pw2,pw3;
  #define PKW(P,B) cvtpk_s(P[B],P[B+1])
  #define PAF(k) __builtin_bit_cast(bf16x8,pw##k)
  #define VFR(i) (bf16x8){vlo[i][0],vlo[i][1],vlo[i][2],vlo[i][3],vhi[i][0],vhi[i][1],vhi[i][2],vhi[i][3]}
  #define PIN(x) asm volatile("":"+v"(x))
  #define MX3(a,b,c) __builtin_fmaxf(__builtin_fmaxf((a),(b)),(c))
  #define GAPA(MF,A0,A1,A2,A3,W0,W1,PW) do{ MF; sacc+=A0; sacc+=A1; sacc+=A2; sacc+=A3; PIN(sacc); W0; W1; PIN(PW); SBAR(); }while(0)
  #define EX(v) __builtin_amdgcn_exp2f(v)
  #define GAPB(MF,X,B) do{ MF; X[B]=EX(X[B]); X[B+1]=EX(X[B+1]); X[B+2]=EX(X[B+2]); X[B+3]=EX(X[B+3]); PIN(X); SBAR(); }while(0)
  #define VRD(i) do{ vlo[i]=vtr(vp_+(((i)>>2)*4096+((i)&3)*1024)); vhi[i]=vtr(vp_+(((i)>>2)*4096+((i)&3)*1024+512)); }while(0)
  #define KRD(G,j) do{ if(G){ kload2(kf,kp0+sl_next,j); SBAR(); } }while(0)
  #define STEP(C0,C1,P0,P1,t,GK,GV,GL) do{ SBAR(); \
    const lds_cptr vp_=vp0+sl_prev; \
    VRD(0); SBAR(); float sacc=(P0[0]+P0[1]); \
    GAPA(C0=__builtin_amdgcn_mfma_f32_32x32x16_bf16(kf[0],qr[0],negm,0,0,0), P0[2],P0[3],P0[4],P0[5],     pw0[0]=PKW(P0,0), pw0[1]=PKW(P0,2), pw0); \
    VRD(4); SBAR(); GAPA(C1=__builtin_amdgcn_mfma_f32_32x32x16_bf16(kf[1],qr[0],negm,0,0,0), P0[6],P0[7],P0[8],P0[9],     pw0[2]=PKW(P0,4), pw0[3]=PKW(P0,6), pw0); \
    VRD(1); SBAR(); GAPA(C0=__builtin_amdgcn_mfma_f32_32x32x16_bf16(kf[2],qr[1],C0,0,0,0),   P0[10],P0[11],P0[12],P0[13], pw1[0]=PKW(P0,8), pw1[1]=PKW(P0,10), pw1); \
    VRD(5); SBAR(); GAPA(C1=__builtin_amdgcn_mfma_f32_32x32x16_bf16(kf[3],qr[1],C1,0,0,0),   P0[14],P0[15],P1[0],P1[1],   pw1[2]=PKW(P0,12),pw1[3]=PKW(P0,14), pw1); \
    VRD(2); SBAR(); GAPA(C0=__builtin_amdgcn_mfma_f32_32x32x16_bf16(kf[4],qr[2],C0,0,0,0),   P1[2],P1[3],P1[4],P1[5],     pw2[0]=PKW(P1,0), pw2[1]=PKW(P1,2), pw2); \
    VRD(6); SBAR(); GAPA(C1=__builtin_amdgcn_mfma_f32_32x32x16_bf16(kf[5],qr[2],C1,0,0,0),   P1[6],P1[7],P1[8],P1[9],     pw2[2]=PKW(P1,4), pw2[3]=PKW(P1,6), pw2); \
    VRD(3); SBAR(); GAPA(C0=__builtin_amdgcn_mfma_f32_32x32x16_bf16(kf[6],qr[3],C0,0,0,0),   P1[10],P1[11],P1[12],P1[13], pw3[0]=PKW(P1,8), pw3[1]=PKW(P1,10), pw3); \
    VRD(7); SBAR(); GAPA(C1=__builtin_amdgcn_mfma_f32_32x32x16_bf16(kf[7],qr[3],C1,0,0,0),   P1[14],P1[15],0.f,0.f,       pw3[2]=PKW(P1,12),pw3[3]=PKW(P1,14), pw3); \
    l_reg+=sacc; \
    if(GK){DMA_K((t)+3,sl_cur);} if(GV){DMA_V((t)+1,sl_next);} \
    CMASK(C0,C1,t); \
    { float a=MX3(C0[0],C0[1],C1[0]),b=MX3(C0[2],C0[3],C1[1]); a=MX3(a,C1[2],C1[3]); \
      _Pragma("unroll") for(int r=4;r<16;r+=4){a=MX3(a,C0[r],C0[r+1]);b=MX3(b,C0[r+2],C0[r+3]);a=MX3(a,C1[r],C1[r+1]);b=MX3(b,C1[r+2],C1[r+3]);} \
      float rm=__builtin_fmaxf(a,b); { auto rr=__builtin_amdgcn_permlane32_swap(__float_as_uint(rm),__float_as_uint(rm),false,false); rm=__builtin_fmaxf(__uint_as_float(rr[0]),__uint_as_float(rr[1])); } \
      resc=false; \
      if(__builtin_expect(__any(rm>(float)THRL),0)){ const float dl=__builtin_fmaxf(rm,0.f); mhat+=dl; \
        _Pragma("unroll") for(int r=0;r<16;++r){C0[r]-=dl;C1[r]-=dl;} \
        _Pragma("unroll") for(int r=0;r<16;++r)negm[r]=-mhat; asm volatile("":"+v"(negm)); \
        const float f=__builtin_amdgcn_exp2f(-dl); l_reg*=f; if(hi==0)wsf[r32]=f; resc=true; } } \
    SBAR(); \
    GAPB(o[0]=__builtin_amdgcn_mfma_f32_32x32x16_bf16(PAF(0),VFR(0),o[0],0,0,0), C0,0); \
    GAPB(o[1]=__builtin_amdgcn_mfma_f32_32x32x16_bf16(PAF(0),VFR(4),o[1],0,0,0), C0,4); \
    KRD(GL,0); GAPB(o[0]=__builtin_amdgcn_mfma_f32_32x32x16_bf16(PAF(1),VFR(1),o[0],0,0,0), C0,8); \
    KRD(GL,1); GAPB(o[1]=__builtin_amdgcn_mfma_f32_32x32x16_bf16(PAF(1),VFR(5),o[1],0,0,0), C0,12); \
    KRD(GL,2); GAPB(o[0]=__builtin_amdgcn_mfma_f32_32x32x16_bf16(PAF(2),VFR(2),o[0],0,0,0), C1,0); \
    KRD(GL,3); GAPB(o[1]=__builtin_amdgcn_mfma_f32_32x32x16_bf16(PAF(2),VFR(6),o[1],0,0,0), C1,4); \
    GAPB(o[0]=__builtin_amdgcn_mfma_f32_32x32x16_bf16(PAF(3),VFR(3),o[0],0,0,0), C1,8); \
    GAPB(o[1]=__builtin_amdgcn_mfma_f32_32x32x16_bf16(PAF(3),VFR(7),o[1],0,0,0), C1,12); \
    }while(0)
  int t=1;
  #undef CMASK
  #define CMASK(P0,P1,t) do{}while(0)
  for(;t+5<NT;t+=2){
    STEP(pB0,pB1,pA0,pA1,t,true,true,true);     WAIT_BAR(2); RESC(); ROT();
    STEP(pA0,pA1,pB0,pB1,t+1,true,true,true);   WAIT_BAR(2); RESC(); ROT();
  }
  #undef CMASK
  #define CMASK(P0,P1,t) do{}while(0)
  #define ENDW(tt) do{ if((tt)+3<NT){WAIT_BAR(2);} else if((tt)+2<NT){WAIT_BAR(1);} else {WAIT_BAR(0);} }while(0)
  for(;t+1<NT;t+=2){
    STEP(pB0,pB1,pA0,pA1,t,(t+3<NT),(t+1<NT),(t+1<NT));       ENDW(t);   RESC(); ROT();
    STEP(pA0,pA1,pB0,pB1,t+1,(t+4<NT),(t+2<NT),(t+2<NT));     ENDW(t+1); RESC(); ROT();
  }
  STEP(pB0,pB1,pA0,pA1,NT-1,false,false,false); RESC();
  { float sacc=pB0[0]+pB0[1]; _Pragma("unroll") for(int r=2;r<16;++r)sacc+=pB0[r]; _Pragma("unroll") for(int r=0;r<16;++r)sacc+=pB1[r]; l_reg+=sacc;
    pw0=(u32x4){PKW(pB0,0),PKW(pB0,2),PKW(pB0,4),PKW(pB0,6)};pw1=(u32x4){PKW(pB0,8),PKW(pB0,10),PKW(pB0,12),PKW(pB0,14)};pw2=(u32x4){PKW(pB1,0),PKW(pB1,2),PKW(pB1,4),PKW(pB1,6)};pw3=(u32x4){PKW(pB1,8),PKW(pB1,10),PKW(pB1,12),PKW(pB1,14)};
    SBAR(); pv(o,vb0+sl_cur,PAF(0),PAF(1),PAF(2),PAF(3)); }
  #undef PKW
  #undef PAF
  #undef VFR
  #undef PIN
  #undef MX3
  #undef GAPA
  #undef GAPB
  #undef EX
  #undef VRD
  #undef KRD
  #undef STEP
  #undef ENDW
  {auto rr=__builtin_amdgcn_permlane32_swap(__float_as_uint(l_reg),__float_as_uint(l_reg),false,false);l_reg=__uint_as_float(rr[0])+__uint_as_float(rr[1]);}
  if(hi==0)wsf[32+r32]=l_reg;asm volatile("s_waitcnt lgkmcnt(0)":::"memory");
  float rli[16];
  #pragma unroll
  for(int r=0;r<16;++r)rli[r]=__builtin_amdgcn_rcpf(wsf[32+crow(r,hi)]);
  bf16*Ow=O+(rowbase+q0+wid*QBLK)*OP+h*D;
  { bf16*stg=(bf16*)(shm+LDS_OST)+wid*2048;
    #pragma unroll
    for(int r=0;r<16;++r){const int orow=crow(r,hi);
      #pragma unroll
      for(int d0=0;d0<2;++d0)stg[orow*64+d0*32+r32]=__float2bfloat16(o[d0][r]*rli[r]);}
    asm volatile("s_waitcnt lgkmcnt(0)":::"memory");
    #pragma unroll
    for(int i=0;i<4;++i){const int row=i*8+(lane>>3),ch=lane&7; const u32x4 v=*(const u32x4*)(stg+row*64+ch*8); ATTN_STORE16(Ow+(long)row*OP+ch*8,v);} }
  asm volatile("s_waitcnt lgkmcnt(0)\n\ts_barrier":::"memory");
  #undef DMA_K
  #undef DMA_V
  #undef CMASK
  #undef START
  #undef RESC
  #undef ROT
}
constexpr int ATTN_LDS_BYTES=LDS_BYTES;
struct AttnTensors { const bf16* Q; const bf16* K; const bf16* V; bf16* O; };
struct AttnUnit { int bh; int qb; };
struct StaticOrder {
  int vcu, per;
  __device__ __forceinline__ explicit StaticOrder(int grid,int block){ vcu=(grid%8==0)?(block%8)*(grid/8)+block/8:block; per=(1024+grid-1)/grid; }
  __device__ __forceinline__ bool next(int i,AttnUnit&u)const{ if(i>=per)return false; const int idx=vcu*per+i; if(idx>=1024)return false;
    const int bkv=idx>>6, hl=(idx&63)>>4; u.bh=(bkv>>1)*NHEAD+(bkv&1)*4+hl; u.qb=idx&15; return true; }
  __device__ __forceinline__ void a_ready(const AttnUnit&)const{}
  __device__ __forceinline__ void done(const AttnUnit&)const{}
};
template<class Sched,int THRL=8> __device__ __forceinline__ void attn_phase(char*lds,const AttnTensors&T,const Sched&S){
  AttnUnit u;
  for(int i=0;S.next(i,u);++i){ S.a_ready(u); attn_unit<THRL>(u.bh/NHEAD,u.bh%NHEAD,u.qb,T.Q,T.K,T.V,T.O,lds); S.done(u); }
}
#undef SBAR
#undef WAIT_BAR
}
#define GAS __attribute__((address_space(1)))
#define LAS __attribute__((address_space(3)))
typedef unsigned short bf16_t;
typedef unsigned v4u __attribute__((ext_vector_type(4)));
typedef unsigned v2u __attribute__((ext_vector_type(2)));
typedef float f32x4 __attribute__((ext_vector_type(4)));
typedef float f32x16 __attribute__((ext_vector_type(16)));
typedef float f32x2 __attribute__((ext_vector_type(2)));
typedef short bf16x8 __attribute__((ext_vector_type(8)));
using pg8::cvt_pk_bf16; using pg8::bflo; using pg8::bfhi; using pg8::gelu_tanh; using pg8::sigmoidf_;

constexpr int NWAVES = 8, NTHR = 512;
constexpr int BATCH = 8, SEQ = 4096, DM = 1024, MTOK = BATCH * SEQ, DFF = 4096, DEPTH = 4;
constexpr int LDS_BYTES = 147456;
constexpr size_t MiB = 1u << 20;
constexpr size_t WS_ROPE = 512 * 1024, WS_MOD = 1 * MiB, WS_SHW1 = 2 * MiB, WS_SHW2 = WS_SHW1 + 256 * 1024, WS_ROWSS = 3 * MiB, WS_A32 = 5 * MiB;
constexpr size_t WS_WHIN = 6 * MiB, WS_WHOUT = 11 * MiB, WS_WGLU = 15 * MiB, WS_WRIN = 16 * MiB, WS_WROUT = 24 * MiB, WS_W1 = 28 * MiB, WS_W2 = 60 * MiB;
constexpr size_t WS_TT = 92 * MiB, WS_PT = 140 * MiB, WS_HW = 156 * MiB, WS_R = 220 * MiB, WS_END = 476 * MiB;
constexpr size_t R_AP = WS_R, R_Q = WS_R + 48 * MiB, R_K = WS_R + 80 * MiB, R_V = WS_R + 88 * MiB, R_E = WS_R + 96 * MiB, R_G = WS_R + 128 * MiB, R_MIX = WS_R + 192 * MiB;
constexpr size_t R_Z = WS_R, R_HF = WS_R + 128 * MiB, R_HID = WS_R;
constexpr size_t TT_LAYER = (size_t)32 * 512 * 768, PT_LAYER = (size_t)32 * 256 * 512;

__device__ __forceinline__ f32x2 mk2(float a, float b) { f32x2 r; r.x = a; r.y = b; return r; }
__device__ __forceinline__ float wave_sum(float v, int lane) {
#pragma unroll
    for (int o = 1; o < 64; o <<= 1) v += shx(v, o, lane);
    return v;
}
__device__ __forceinline__ unsigned f2bf(float f) { unsigned u = __builtin_bit_cast(unsigned, f); return (u + 0x7fffu + ((u >> 16) & 1u)) >> 16; }
__device__ __forceinline__ unsigned pk2(float lo, float hi) { return f2bf(lo) | (f2bf(hi) << 16); }
__device__ __forceinline__ void dcis(double ang, double& c, double& s) {
    const double n = __builtin_rint(ang * 0.15915494309189535);
    const double r = __builtin_fma(-n, 6.283185307179586, ang);
    const double x = r * 0.0625, x2 = x * x;
    double sn = x * (1.0 + x2 * (-1.0 / 6.0 + x2 * (1.0 / 120.0 + x2 * (-1.0 / 5040.0 + x2 * (1.0 / 362880.0 + x2 * (-1.0 / 39916800.0 + x2 * (1.0 / 6227020800.0)))))));
    double cs = 1.0 + x2 * (-0.5 + x2 * (1.0 / 24.0 + x2 * (-1.0 / 720.0 + x2 * (1.0 / 40320.0 + x2 * (-1.0 / 3628800.0 + x2 * (1.0 / 479001600.0))))));
#pragma unroll
    for (int i = 0; i < 4; ++i) { const double c2 = cs * cs - sn * sn, s2 = 2.0 * cs * sn; cs = c2; sn = s2; }
    c = cs; s = sn;
}
__device__ __forceinline__ double dexp_small(double x) {
    const double y = x * (1.0 / 64.0);
    double e = 1.0 + y * (1.0 + y * (0.5 + y * (1.0 / 6.0 + y * (1.0 / 24.0 + y * (1.0 / 120.0 + y * (1.0 / 720.0 + y * (1.0 / 5040.0 + y * (1.0 / 40320.0))))))));
#pragma unroll
    for (int i = 0; i < 6; ++i) e = e * e;
    return e;
}

__device__ __forceinline__ void p0_transpose_item(const float* W, int K, int N, bf16_t* WT, LAS float* scr, int item, int lane) {
    const int nblk = N / 64, kb = item / nblk, nb = item % nblk, k0 = 64 * kb, n0 = 64 * nb;
    f32x4 v[16];
#pragma unroll
    for (int i = 0; i < 16; ++i) v[i] = *(const f32x4*)(W + (size_t)(k0 + (lane >> 4) + 4 * i) * N + n0 + 4 * (lane & 15));
#pragma unroll
    for (int i = 0; i < 16; ++i) { LAS float* d = scr + ((lane >> 4) + 4 * i) * 65 + 4 * (lane & 15); d[0] = v[i][0]; d[1] = v[i][1]; d[2] = v[i][2]; d[3] = v[i][3]; }
    asm volatile("s_waitcnt lgkmcnt(0)" ::: "memory");
    const int c = lane & 7;
#pragma unroll
    for (int j = 0; j < 8; ++j) { const int n = (lane >> 3) + 8 * j; const LAS float* s = scr + (8 * c) * 65 + n;
        v4u o; o.x = pk2(s[0 * 65], s[1 * 65]); o.y = pk2(s[2 * 65], s[3 * 65]); o.z = pk2(s[4 * 65], s[5 * 65]); o.w = pk2(s[6 * 65], s[7 * 65]);
        *(v4u*)(WT + (size_t)(n0 + n) * K + k0 + 8 * c) = o; }
    asm volatile("s_waitcnt lgkmcnt(0)" ::: "memory");
}
__device__ __forceinline__ void skinny_gemm(const LAS float* Al, LAS float* red, const float* W, int ldw, int col0, float* out, int ldo, const float* bias, int tid) {
    const int wave = tid >> 6, lane = tid & 63;
    float acc[8];
#pragma unroll
    for (int b = 0; b < 8; ++b) acc[b] = 0.f;
    const float* wp = W + (size_t)(128 * wave) * ldw + col0 + lane;
#pragma unroll 4
    for (int k4 = 0; k4 < 32; ++k4) {
        const float w0 = wp[(size_t)(4 * k4) * ldw], w1 = wp[(size_t)(4 * k4 + 1) * ldw], w2 = wp[(size_t)(4 * k4 + 2) * ldw], w3 = wp[(size_t)(4 * k4 + 3) * ldw];
#pragma unroll
        for (int b = 0; b < 8; ++b) { const f32x4 a4 = *(const LAS f32x4*)(Al + b * 1024 + 128 * wave + 4 * k4); acc[b] += (a4[0] * w0 + a4[1] * w1) + (a4[2] * w2 + a4[3] * w3); }
    }
#pragma unroll
    for (int b = 0; b < 8; ++b) red[(wave * 8 + b) * 64 + lane] = acc[b];
    __syncthreads();
    { const int b = tid >> 6; float s = 0.f;
#pragma unroll
      for (int w = 0; w < 8; ++w) s += red[(w * 8 + b) * 64 + lane];
      out[(size_t)b * ldo + col0 + lane] = s + (bias ? bias[col0 + lane] : 0.f); }
    __syncthreads();
}

__device__ __forceinline__ void s5_tables(int e, int g, const float* lam_re, const float* lam_im, const float* log_dt, const float* b_re, const float* b_im, const float* c_re, const float* c_im,
                                          bf16_t* TT, bf16_t* PT, f32x2* A32, LAS unsigned char* lds, int tid) {
    LAS f32x2* PW = (LAS f32x2*)lds;
    LAS f32x2* BB = PW + 2 * 64 * 33;
    LAS f32x2* CC = BB + 2 * 64 * 16;
    LAS float* KF = (LAS float*)(CC + 2 * 16 * 65);
    if (tid < 128) {
        const int d = tid >> 6, p = tid & 63;
        const int li_ = ((e * 2 + d) * 32 + g) * 64 + p;
        const double lr = (double)fminf(lam_re[li_], -1e-4f), li = (double)lam_im[li_];
        const double dt = dexp_small((double)log_dt[(e * 2 + d) * 32 + g] * 0.25); const double dt4 = (dt * dt) * (dt * dt);
        double ar1 = 1.0, ai1 = 0.0;
        for (int tau = 0; tau <= 32; ++tau) {
            const double mag = dexp_small((double)tau * lr * dt4);
            double c, s; dcis((double)tau * li * dt4, c, s);
            PW[(d * 64 + p) * 33 + tau] = mk2((float)(mag * c), (float)(mag * s));
            if (tau == 1) { ar1 = mag * c; ai1 = mag * s; }
            if (tau == 32) A32[(g * 2 + d) * 64 + p] = mk2((float)(mag * c), (float)(mag * s));
        }
        const double den = lr * lr + li * li, nr = ar1 - 1.0;
        const double fre = (nr * lr + ai1 * li) / den, fim = (ai1 * lr - nr * li) / den;
        for (int c = 0; c < 16; ++c) { const double br = (double)b_re[(size_t)li_ * 16 + c], bi = (double)b_im[(size_t)li_ * 16 + c];
            BB[(d * 64 + p) * 16 + c] = mk2((float)(fre * br - fim * bi), (float)(fre * bi + fim * br)); }
    }
#pragma unroll
    for (int i = 0; i < 4; ++i) { const int idx = tid + 512 * i; const int d = idx >> 10, r = idx & 1023;
        const size_t src = (size_t)((e * 2 + d) * 32 + g) * 1024 + r; CC[(idx >> 6) * 65 + (idx & 63)] = mk2(c_re[src], c_im[src]); }
    __syncthreads();
    {   const int d = tid >> 8, c = (tid >> 4) & 15, cp = tid & 15;
        float kacc[32];
#pragma unroll
        for (int t = 0; t < 32; ++t) kacc[t] = 0.f;
        for (int p = 0; p < 64; ++p) {
            const f32x2 cc = CC[(d * 16 + c) * 65 + p], bb = BB[(d * 64 + p) * 16 + cp];
            const float cbr = cc.x * bb.x - cc.y * bb.y, cbi = cc.x * bb.y + cc.y * bb.x;
#pragma unroll
            for (int t = 0; t < 32; ++t) { const f32x2 pw = PW[(d * 64 + p) * 33 + t]; kacc[t] += cbr * pw.x - cbi * pw.y; }
        }
#pragma unroll
        for (int t = 0; t < 32; ++t) KF[(d * 32 + t) * 260 + c * 16 + cp] = kacc[t];
    }
    __syncthreads();
    for (int i = 0; i < 64; ++i) {
        const int idx = tid + 512 * i, n = idx >> 6, ch = idx & 63, sl = ch >> 1, cp0 = (ch & 1) * 8, tl = n >> 4, c = n & 15;
        f32x4 va = (f32x4){0.f, 0.f, 0.f, 0.f}, vb = va;
        if (tl >= sl) { const LAS f32x4* s = (const LAS f32x4*)(KF + (tl - sl) * 260 + c * 16 + cp0); va += s[0]; vb += s[1]; }
        if (sl >= tl) { const LAS f32x4* s = (const LAS f32x4*)(KF + (32 + sl - tl) * 260 + c * 16 + cp0); va += s[0]; vb += s[1]; }
        v4u o; o.x = pk2(va[0], va[1]); o.y = pk2(va[2], va[3]); o.z = pk2(vb[0], vb[1]); o.w = pk2(vb[2], vb[3]);
        *(v4u*)(TT + ((size_t)(g * 512 + n) * 768 + sl * 16 + cp0)) = o;
    }
    for (int i = 0; i < 32; ++i) {
        const int n = tid, ch = i, col0 = ch * 8, q = col0 >> 6, p0 = col0 & 63, d = q >> 1, tl = n >> 4, c = n & 15;
        const int tau = d == 0 ? tl + 1 : 32 - tl;
        float v[8];
#pragma unroll
        for (int j = 0; j < 8; ++j) { const f32x2 cc = CC[(d * 16 + c) * 65 + p0 + j], pw = PW[(d * 64 + p0 + j) * 33 + tau];
            const float wr_ = cc.x * pw.x - cc.y * pw.y, wi_ = cc.x * pw.y + cc.y * pw.x; v[j] = (q & 1) ? -wi_ : wr_; }
        v4u o; o.x = pk2(v[0], v[1]); o.y = pk2(v[2], v[3]); o.z = pk2(v[4], v[5]); o.w = pk2(v[6], v[7]);
        *(v4u*)(TT + ((size_t)(g * 512 + n) * 768 + 512 + col0)) = o;
    }
    for (int i = 0; i < 32; ++i) {
        const int idx = tid + 512 * i, n = idx >> 6, ch = idx & 63, sl = ch >> 1, cp0 = (ch & 1) * 8, d = n >> 7, ri = (n >> 6) & 1, p = n & 63;
        const int tau = d == 0 ? 31 - sl : sl;
        const f32x2 pw = PW[(d * 64 + p) * 33 + tau];
        float v[8];
#pragma unroll
        for (int j = 0; j < 8; ++j) { const f32x2 bb = BB[(d * 64 + p) * 16 + cp0 + j]; v[j] = ri ? (pw.x * bb.y + pw.y * bb.x) : (pw.x * bb.x - pw.y * bb.y); }
        v4u o; o.x = pk2(v[0], v[1]); o.y = pk2(v[2], v[3]); o.z = pk2(v[4], v[5]); o.w = pk2(v[6], v[7]);
        *(v4u*)(PT + ((size_t)(g * 256 + n) * 512 + sl * 16 + cp0)) = o;
    }
    __syncthreads();
}

__device__ __forceinline__ void rope_table(f32x2* gtab, int tid) {
    for (int idx = tid; idx < 1024; idx += NTHR) { const int pos = idx >> 4, f = idx & 15;
        const float invf = __builtin_amdgcn_exp2f(-(float)f * (13.287712379549449f / 16.0f));
        double c, s; dcis((double)((float)pos * invf), c, s); gtab[idx] = mk2((float)c, (float)s); }
}
__device__ __forceinline__ void qkprep_phase(bf16_t* Q, bf16_t* Kb, const float* qn, const float* kn, const f32x2* gtab, LAS unsigned char* lds, int tid, int gw, int ngw) {
    LAS f32x2* tab = (LAS f32x2*)lds;
    for (int idx = tid; idx < 1024; idx += NTHR) tab[idx] = gtab[idx];
    __syncthreads();
    const int lane = tid & 63, j = lane & 7;
    const int axis = j >> 2, fb = (j & 1) * 8; const bool second = (j & 2) != 0;
    const float C2 = 0.125f * 1.4426950408889634f;
    for (int it = gw; it < MTOK + MTOK / 4; it += ngw) {
        bf16_t* ptr; const float* nwp; int tok; float scale;
        if (it < MTOK) { tok = it; ptr = Q + (size_t)tok * 512 + lane * 8; nwp = qn; scale = C2; }
        else { tok = (it - MTOK) * 4 + (lane >> 4); ptr = Kb + (size_t)tok * 128 + (lane & 15) * 8; nwp = kn; scale = 1.0f; }
        const int s = tok & 4095, pos = axis == 0 ? (s >> 6) : (s & 63);
        const v4u raw = *(const v4u*)ptr;
        float x[8] = {bflo(raw.x), bfhi(raw.x), bflo(raw.y), bfhi(raw.y), bflo(raw.z), bfhi(raw.z), bflo(raw.w), bfhi(raw.w)};
        float ss = 0.f;
#pragma unroll
        for (int i = 0; i < 8; ++i) ss += x[i] * x[i];
        ss += shx(ss, 1, lane); ss += shx(ss, 2, lane); ss += shx(ss, 4, lane);
        const float rs = 1.0f / sqrtf(ss * (1.0f / 64.0f) + 1e-6f);
        const f32x4 w0 = *(const f32x4*)(nwp + j * 8), w1 = *(const f32x4*)(nwp + j * 8 + 4);
        float y[8], o[8];
#pragma unroll
        for (int i = 0; i < 8; ++i) y[i] = x[i] * rs * (i < 4 ? w0[i] : w1[i - 4]);
#pragma unroll
        for (int i = 0; i < 8; ++i) { const float pr = shx(y[i], 2, lane); const f32x2 cs = tab[pos * 16 + fb + i];
            o[i] = (second ? (y[i] * cs.x + pr * cs.y) : (y[i] * cs.x - pr * cs.y)) * scale; }
        v4u w; w.x = cvt_pk_bf16(o[0], o[1]); w.y = cvt_pk_bf16(o[2], o[3]); w.z = cvt_pk_bf16(o[4], o[5]); w.w = cvt_pk_bf16(o[6], o[7]);
        *(v4u*)ptr = w;
    }
}

__device__ __forceinline__ void s5_scan_phase(const float* E, bf16_t* AP, const f32x2* A32, LAS unsigned char* lds, int tid, int bid, int G) {
    LAS f32x2* XC = (LAS f32x2*)lds;
    for (int it = bid; it < 256; it += G) {
        const int g = it & 31, b = it >> 5;
        const int st = tid & 127, seg = tid >> 7, d = st >> 6, p = st & 63;
        const f32x2 a = A32[(g * 2 + d) * 64 + p];
        const float* Eb = E + (size_t)(g * 1024 + b * 128) * 256 + d * 128 + p;
        bf16_t* Hb = AP + (size_t)(g * 1024 + b * 128) * 768 + 512 + d * 128 + p;
        float er[32], ei[32];
#pragma unroll
        for (int j = 0; j < 32; ++j) { const int q = 32 * seg + j, k = d ? 127 - q : q; er[j] = Eb[(size_t)k * 256]; ei[j] = Eb[(size_t)k * 256 + 64]; }
        float hr = 0.f, hi = 0.f;
#pragma unroll
        for (int j = 0; j < 32; ++j) { const float xr = er[j], xi = ei[j]; er[j] = hr; ei[j] = hi; const float nr = a.x * hr - a.y * hi + xr, ni = a.x * hi + a.y * hr + xi; hr = nr; hi = ni; }
        XC[seg * 128 + st] = mk2(hr, hi);
        float pr = a.x, pi = a.y;
#pragma unroll
        for (int i = 0; i < 5; ++i) { const float nr = pr * pr - pi * pi, ni = 2.f * pr * pi; pr = nr; pi = ni; }
        __syncthreads();
        float cr = 0.f, ci = 0.f;
        for (int s = 0; s < seg; ++s) { const f32x2 x = XC[s * 128 + st]; const float nr = pr * cr - pi * ci + x.x, ni = pr * ci + pi * cr + x.y; cr = nr; ci = ni; }
#pragma unroll
        for (int j = 0; j < 32; ++j) { const int q = 32 * seg + j, k = d ? 127 - q : q;
            Hb[(size_t)k * 768] = (bf16_t)f2bf(er[j] + cr); Hb[(size_t)k * 768 + 64] = (bf16_t)f2bf(ei[j] + ci);
            const float nr = a.x * cr - a.y * ci, ni = a.x * ci + a.y * cr; cr = nr; ci = ni; }
        __syncthreads();
    }
}

__device__ __forceinline__ float frcp(float x) { return __builtin_amdgcn_rcpf(x); }
__device__ __forceinline__ float fsig(float x) { return frcp(1.0f + __builtin_amdgcn_exp2f(-1.4426950408889634f * x)); }
__device__ __forceinline__ float fgelu(float x) { const float z = 0.7978845608028654f * (x + 0.044715f * x * x * x); return x * frcp(1.0f + __builtin_amdgcn_exp2f(-2.8853900817779268f * z)); }
__device__ __forceinline__ void rglru_phase(int o, const bf16_t* Z, bf16_t* HF, bf16_t* MIX, const float* conv_w, const float* conv_b, const float* ra_w, const float* ra_b,
                                            const float* ix_w, const float* ix_b, const float* lam, LAS unsigned char* lds, int tid, int bid, int G) {
    LAS bf16_t* XA = (LAS bf16_t*)lds;
    LAS float* SA = (LAS float*)(lds + 36864);
    LAS float* SB = SA + 256 * 33;
    LAS float* SEGA = SB + 256 * 33;
    LAS float* SEGB = SEGA + 512;
    LAS float* CAR = SEGB + 512;
    LAS bf16_t* RAW = (LAS bf16_t*)(lds + 36864 + 67584 + 4096 + 256);
    const int wave = tid >> 6, lane = tid & 63, n32 = lane & 31, hi = lane >> 5;
    for (int unit = bid; unit < 256; unit += G) {
        const int b = unit >> 5, hd = (unit & 31) >> 1, hf = unit & 1;
        const int ic0 = 64 * hd, oc0 = ic0 + 32 * hf, cg = tid & 7;
        float cw[4][8], cb[8];
#pragma unroll
        for (int i = 0; i < 8; ++i) { cb[i] = conv_b[o * 1024 + ic0 + 8 * cg + i];
#pragma unroll
            for (int j = 0; j < 4; ++j) cw[j][i] = conv_w[(o * 4 + j) * 1024 + ic0 + 8 * cg + i]; }
        const bf16_t* Zx = Z + (size_t)b * SEQ * 2048 + 1024 + ic0;
#pragma unroll 1
        for (int dir = 0; dir < 2; ++dir) {
            bf16x8 BR[4], BI[4];
#pragma unroll
            for (int ks = 0; ks < 4; ++ks)
#pragma unroll
                for (int i = 0; i < 8; ++i) { const int k = 16 * ks + 8 * hi + i; const size_t off = ((size_t)((o * 2 + dir) * 16 + hd) * 64 + k) * 64 + 32 * hf + n32;
                    BR[ks][i] = (short)f2bf(ra_w[off]); BI[ks][i] = (short)f2bf(ix_w[off]); }
            const int och = oc0 + n32;
            const float rab = ra_b[(o * 2 + dir) * 1024 + och], ixb = ix_b[(o * 2 + dir) * 1024 + och];
            const float lm = lam[(o * 2 + dir) * 1024 + och];
            const float sp8 = 8.0f * 1.4426950408889634f * (fmaxf(-lm, 0.f) + log1pf(__expf(-fabsf(lm))));
            if (tid < 32) CAR[tid] = 0.f;
            v4u pre[5];
            {   const int t0 = dir ? 256 * 15 : 0;
#pragma unroll
                for (int k = 0; k < 5; ++k) { const int idx = tid + 512 * k, r = idx >> 3, p8 = idx & 7, ts = t0 - 2 + r;
                    pre[k] = (v4u){0u, 0u, 0u, 0u};
                    if (idx < 2072 && ts >= 0 && ts < SEQ) pre[k] = *(const v4u*)(Zx + (size_t)ts * 2048 + 8 * p8); }
            }
#pragma unroll 1
            for (int ci = 0; ci < 16; ++ci) {
                const int c = dir ? 15 - ci : ci, t0 = 256 * c;
                const int tid = otid(), wave = tid >> 6, lane = tid & 63, n32 = lane & 31, hi = lane >> 5, cg = tid & 7;
#pragma unroll
                for (int k = 0; k < 5; ++k) { const int idx = tid + 512 * k, r = idx >> 3, p8 = idx & 7; if (idx < 2072) *(LAS v4u*)(RAW + r * 72 + 8 * p8) = pre[k]; }
                __syncthreads();
                if (ci < 15) { const int tn = dir ? t0 - 256 : t0 + 256;
#pragma unroll
                    for (int k = 0; k < 5; ++k) { const int idx = tid + 512 * k, r = idx >> 3, p8 = idx & 7, ts = tn - 2 + r;
                        pre[k] = (v4u){0u, 0u, 0u, 0u};
                        if (idx < 2072 && ts >= 0 && ts < SEQ) pre[k] = *(const v4u*)(Zx + (size_t)ts * 2048 + 8 * p8); } }
                v4u gtv[2], hfv[2];
                if (dir) {
#pragma unroll
                    for (int i2 = 0; i2 < 2; ++i2) { const int idx = tid + 512 * i2, tt = idx >> 2, c8 = (idx & 3) * 8; const size_t m = (size_t)b * SEQ + t0 + tt;
                        gtv[i2] = *(const v4u*)(Z + m * 2048 + oc0 + c8); hfv[i2] = *(const v4u*)(HF + m * 1024 + oc0 + c8); } }
#pragma unroll 2
                for (int i4 = 0; i4 < 4; ++i4) {
                    const int tt = (tid >> 3) + 64 * i4;
                    float xc[8];
#pragma unroll
                    for (int i = 0; i < 8; ++i) xc[i] = cb[i];
#pragma unroll
                    for (int j = 0; j < 4; ++j) { const v4u raw = *(const LAS v4u*)(RAW + (tt + j) * 72 + 8 * cg);
                        xc[0] += cw[j][0] * bflo(raw.x); xc[1] += cw[j][1] * bfhi(raw.x); xc[2] += cw[j][2] * bflo(raw.y); xc[3] += cw[j][3] * bfhi(raw.y);
                        xc[4] += cw[j][4] * bflo(raw.z); xc[5] += cw[j][5] * bfhi(raw.z); xc[6] += cw[j][6] * bflo(raw.w); xc[7] += cw[j][7] * bfhi(raw.w); }
                    v4u w; w.x = cvt_pk_bf16(xc[0], xc[1]); w.y = cvt_pk_bf16(xc[2], xc[3]); w.z = cvt_pk_bf16(xc[4], xc[5]); w.w = cvt_pk_bf16(xc[6], xc[7]);
                    *(LAS v4u*)(XA + tt * 72 + 8 * cg) = w;
                    if ((cg >> 2) == hf) {
#pragma unroll
                        for (int i = 0; i < 8; ++i) SB[tt * 33 + (8 * cg - 32 * hf) + i] = xc[i]; }
                }
                __syncthreads();
                f32x16 accR = {}, accI = {};
#pragma unroll
                for (int ks = 0; ks < 4; ++ks) { const bf16x8 a = *(const LAS bf16x8*)(XA + (32 * wave + n32) * 72 + 16 * ks + 8 * hi);
                    accR = __builtin_amdgcn_mfma_f32_32x32x16_bf16(a, BR[ks], accR, 0, 0, 0); accI = __builtin_amdgcn_mfma_f32_32x32x16_bf16(a, BI[ks], accI, 0, 0, 0); }
#pragma unroll
                for (int r = 0; r < 16; ++r) { const int tt = 32 * wave + (r & 3) + 8 * (r >> 2) + 4 * hi;
                    const float rr = fsig(accR[r] + rab), ii = fsig(accI[r] + ixb);
                    const float av = __builtin_amdgcn_exp2f(-sp8 * rr); const float bm = __builtin_amdgcn_sqrtf(fmaxf((1.0f - av) * (1.0f + av), 0.f));
                    const float xcv = SB[tt * 33 + n32];
                    SA[tt * 33 + n32] = av; SB[tt * 33 + n32] = bm * ii * xcv; }
                __syncthreads();
                {   const int seg = tid >> 5, n = tid & 31;
                    float av[16], bv[16];
#pragma unroll
                    for (int i = 0; i < 16; ++i) { const int q = 16 * seg + i, tt = dir ? 255 - q : q; av[i] = SA[tt * 33 + n]; bv[i] = SB[tt * 33 + n]; }
                    float A = 1.f, Bv = 0.f;
#pragma unroll
                    for (int i = 0; i < 16; ++i) { Bv = av[i] * Bv + bv[i]; A *= av[i]; }
                    SEGA[seg * 32 + n] = A; SEGB[seg * 32 + n] = Bv;
                    __syncthreads();
                    float h = CAR[(ci & 1) * 32 + n];
                    for (int s = 0; s < seg; ++s) h = SEGA[s * 32 + n] * h + SEGB[s * 32 + n];
#pragma unroll
                    for (int i = 0; i < 16; ++i) { const int q = 16 * seg + i, tt = dir ? 255 - q : q; h = av[i] * h + bv[i]; SB[tt * 33 + n] = h; }
                    if (seg == 15) CAR[((ci + 1) & 1) * 32 + n] = h;
                }
                __syncthreads();
#pragma unroll
                for (int i2 = 0; i2 < 2; ++i2) { const int idx = tid + 512 * i2, tt = idx >> 2, c8 = (idx & 3) * 8; const size_t m = (size_t)b * SEQ + t0 + tt;
                    float hv[8];
#pragma unroll
                    for (int i = 0; i < 8; ++i) hv[i] = SB[tt * 33 + c8 + i];
                    if (dir == 0) { v4u w; w.x = cvt_pk_bf16(hv[0], hv[1]); w.y = cvt_pk_bf16(hv[2], hv[3]); w.z = cvt_pk_bf16(hv[4], hv[5]); w.w = cvt_pk_bf16(hv[6], hv[7]);
                        *(v4u*)(HF + m * 1024 + oc0 + c8) = w; }
                    else { const v4u f = hfv[i2], gt = gtv[i2];
                        const float y0 = (hv[0] + bflo(f.x)) * fgelu(bflo(gt.x)), y1 = (hv[1] + bfhi(f.x)) * fgelu(bfhi(gt.x));
                        const float y2 = (hv[2] + bflo(f.y)) * fgelu(bflo(gt.y)), y3 = (hv[3] + bfhi(f.y)) * fgelu(bfhi(gt.y));
                        const float y4 = (hv[4] + bflo(f.z)) * fgelu(bflo(gt.z)), y5 = (hv[5] + bfhi(f.z)) * fgelu(bfhi(gt.z));
                        const float y6 = (hv[6] + bflo(f.w)) * fgelu(bflo(gt.w)), y7 = (hv[7] + bfhi(f.w)) * fgelu(bfhi(gt.w));
                        v4u w; w.x = cvt_pk_bf16(y0, y1); w.y = cvt_pk_bf16(y2, y3); w.z = cvt_pk_bf16(y4, y5); w.w = cvt_pk_bf16(y6, y7);
                        *(v4u*)(MIX + m * 1024 + oc0 + c8) = w; }
                }
            }
            __syncthreads();
        }
    }
}
#define RLX_AGENT __ATOMIC_RELAXED, __HIP_MEMORY_SCOPE_AGENT
#define XB_TMO      128
#define XB_XCNT(j)  (256  + 64 * (j))
#define XB_XSUB(j)  (1280 + 64 * (j))
#define XB_XGEN(j)  (2304 + 64 * (j))
#define XB_TOP      3328
#define XB_TOPGEN   3392
#define XCD_BAR_WORDS 3456
#define XB_SPIN_CAP (1u << 18)

__device__ __forceinline__ unsigned xb_ld(unsigned* p)              { return __hip_atomic_load(p, __ATOMIC_RELAXED, __HIP_MEMORY_SCOPE_AGENT); }
__device__ __forceinline__ unsigned xb_add(unsigned* p, unsigned v) { return __hip_atomic_fetch_add(p, v, __ATOMIC_RELAXED, __HIP_MEMORY_SCOPE_AGENT); }
__device__ __forceinline__ unsigned xb_xcc_id() { return (unsigned)__builtin_amdgcn_s_getreg((3 << 11) | 20) & 0xFu; }
#define XB_SPIN(cond, bar) do { unsigned _sp = 0; while (cond) { __builtin_amdgcn_s_sleep(1); \
    if ((++_sp & 255u) == 0u) { if (xb_ld(&(bar)[XB_TMO])) break; if (_sp > XB_SPIN_CAP) { atomicAdd(&(bar)[XB_TMO], 1u); break; } } } } while (0)

struct XcdBarrier {
    unsigned* bar; unsigned x;
    volatile LAS unsigned* st;
};

__device__ __forceinline__ XcdBarrier xcd_barrier_post(unsigned* bar, volatile LAS unsigned* st) {
    XcdBarrier b; b.bar = bar; b.x = xb_xcc_id(); b.st = st;
    if (threadIdx.x == 0) (void)xb_add(&bar[XB_XCNT(b.x)], 1u);
    return b;
}
__device__ __forceinline__ void xcd_barrier_complete(unsigned* bar, unsigned x, unsigned& nloc, unsigned& nx) {
    const unsigned G = gridDim.x * gridDim.y * gridDim.z;
    unsigned sum, cnt, mine, sp = 0u;
    for (;;) {
        sum = 0u; cnt = 0u; mine = 0u;
#pragma unroll
        for (unsigned j = 0; j < 16; ++j) { const unsigned c = xb_ld(&bar[XB_XCNT(j)]); sum += c; cnt += (c > 0u) ? 1u : 0u; mine = (j == x) ? c : mine; }
        if (sum == G) break;
        __builtin_amdgcn_s_sleep(1);
        if ((++sp & 255u) == 0u) { if (xb_ld(&bar[XB_TMO])) break; if (sp > XB_SPIN_CAP) { atomicAdd(&bar[XB_TMO], 1u); break; } }
    }
    nloc = mine > 0u ? mine : 1u; nx = cnt > 0u ? cnt : 1u;
}

__device__ __forceinline__ void xcd_barrier(const XcdBarrier& b) {
    asm volatile("s_waitcnt vmcnt(0)" ::: "memory");
    __syncthreads();
    if (threadIdx.x == 0) {
        unsigned* bar = b.bar;
        __builtin_amdgcn_s_waitcnt(0);
        unsigned nloc = b.st[0], nx = b.st[1];
        if (nloc == 0u) { xcd_barrier_complete(bar, b.x, nloc, nx); b.st[0] = nloc; b.st[1] = nx; }
        const unsigned old = xb_add(&bar[XB_XSUB(b.x)], 1u);
        const unsigned gen = old / nloc;
        if (old + 1u == (gen + 1u) * nloc) {
            __builtin_amdgcn_fence(__ATOMIC_RELEASE, "agent");
            asm volatile("s_waitcnt vmcnt(0)" ::: "memory");
            const unsigned og = xb_add(&bar[XB_TOP], 1u);
            const unsigned tg = og / nx;
            if (og + 1u == (tg + 1u) * nx) xb_add(&bar[XB_TOPGEN], 1u);
            else XB_SPIN(xb_ld(&bar[XB_TOPGEN]) == tg, bar);
            __builtin_amdgcn_fence(__ATOMIC_ACQUIRE, "agent");
            xb_add(&bar[XB_XGEN(b.x)], 1u);
            asm volatile("s_waitcnt vmcnt(0)" ::: "memory");
        } else {
            XB_SPIN(xb_ld(&bar[XB_XGEN(b.x)]) == gen, bar);
            __builtin_amdgcn_fence(__ATOMIC_ACQUIRE, "agent");
            asm volatile("s_waitcnt vmcnt(0)" ::: "memory");
        }
    }
    __syncthreads();
}
struct Args { const float* in[31]; float* out; unsigned char* ws; int ph_lo, ph_hi; };
enum { K_P0 = 0, K_P0B, K_INPROJ, K_S5E, K_ATTN, K_S5Y, K_GLU, K_RGLRU, K_OUTPROJ, K_MLP1, K_MLP2, K_FINAL };
constexpr int NPHASE = 29;
#ifndef DUP_PH
#define DUP_PH (-1)
#define NDUP 0
#endif
constexpr int PTAB_OFF = 146432, DESC_OFF = 146432 + 512, MISC_OFF = 146432 + 768;
typedef unsigned long long u64;
__device__ __forceinline__ u64 ldptr(const LAS u64* t, int i) { const u64 v = t[i]; const unsigned lo = __builtin_amdgcn_readfirstlane((unsigned)v), hi = __builtin_amdgcn_readfirstlane((unsigned)(v >> 32)); return ((u64)hi << 32) | lo; }
#define INP(i) ((const float*)ldptr(PTAB, (i)))
#define WSP(T, off) ((T*)(ws + (off)))

__device__ __forceinline__ void shw_item(int it, const LAS u64* PTAB, unsigned char* ws, LAS unsigned char* lds, int tid) {
    LAS float* Al = (LAS float*)lds; LAS float* red = Al + 8192;
    int r = it, ll = 0, n1b = 20;
    for (ll = 0; ll < 4; ++ll) { n1b = (ll & 1) ? 32 : 20; if (r < n1b + 64) break; r -= n1b + 64; }
    const bool first = r < n1b; const int cbk = first ? r : r - n1b;
    const float* shp = WSP(float, WS_MOD) + (size_t)ll * 8 * 6144 + (first ? 0 : 3072);
    __syncthreads();
    for (int i = tid; i < 8192; i += NTHR) Al[i] = shp[(size_t)(i >> 10) * 6144 + (i & 1023)];
    __syncthreads();
    const float* W; int ldw; float* o; int ldo;
    if (first) { if (ll & 1) { W = INP(22) + (size_t)(ll >> 1) * 1024 * 2048; ldw = 2048; } else { W = INP(8) + (size_t)(ll >> 1) * 1024 * 1280; ldw = 1280; } o = WSP(float, WS_SHW1) + (size_t)ll * 8 * 2048; ldo = 2048; }
    else { W = INP(5) + (size_t)ll * 1024 * 4096; ldw = 4096; o = WSP(float, WS_SHW2) + (size_t)ll * 8 * 4096; ldo = 4096; }
    skinny_gemm(Al, red, W, ldw, cbk * 64, o, ldo, nullptr, tid);
}

__global__ void __launch_bounds__(NTHR) fwd_mega(Args args) {
    extern __shared__ __attribute__((aligned(16))) unsigned char lds_raw[];
    LAS unsigned char* lds0 = (LAS unsigned char*)lds_raw;
    cg::grid_group grid = cg::this_grid();
    if (threadIdx.x == 0) { LAS u64* PT0 = (LAS u64*)(lds0 + PTAB_OFF);
#pragma unroll
        for (int i = 0; i < 31; ++i) PT0[i] = (u64)args.in[i];
        PT0[31] = (u64)args.out; PT0[32] = (u64)args.ws;
    }
    if (threadIdx.x < 2) ((LAS unsigned*)(lds0 + MISC_OFF))[threadIdx.x] = 0u;
    __syncthreads();
    const int ph_lo = args.ph_lo, ph_hi = args.ph_hi;
    const XcdBarrier xbar = xcd_barrier_post((unsigned*)args.ws, (volatile LAS unsigned*)(lds0 + MISC_OFF));

    if (ph_lo == 0) {
        const int tid = otid(), lane = tid & 63, wave = __builtin_amdgcn_readfirstlane(tid >> 6);
        const int G = gridDim.x, bid = blockIdx.x;
        const int vcu = (G % 8 == 0) ? (bid % 8) * (G / 8) + bid / 8 : bid;
        const int gw = vcu * NWAVES + wave, NGW = G * NWAVES;
        LAS unsigned char* lds = lds0; LAS u64* PTAB = (LAS u64*)(lds + PTAB_OFF);
        unsigned char* ws = (unsigned char*)ldptr(PTAB, 32);
        if (bid == 0) rope_table(WSP(f32x2, WS_ROPE), tid);

            for (int it = G - 1 - bid; it < 64; it += G) { const int ee = it >> 5, g = it & 31;
                s5_tables(ee, g, INP(9), INP(10), INP(11), INP(12), INP(13), INP(14), INP(15), WSP(bf16_t, WS_TT) + (size_t)ee * TT_LAYER, WSP(bf16_t, WS_PT) + (size_t)ee * PT_LAYER, WSP(f32x2, WS_A32) + ee * 4096, lds, tid); }
            {   LAS float* Al = (LAS float*)lds; LAS float* red = Al + 8192;
                bool loaded = false;
                const int nmw = (G > 128) ? G - 64 : G;
                for (int it = (bid < nmw ? bid : 4 * 96); it < 4 * 96; it += nmw) {
                    if (!loaded) { const float* cvec = INP(1); for (int i = tid; i < 8192; i += NTHR) { const float v = cvec[i]; Al[i] = v / (1.0f + __expf(-v)); } __syncthreads(); loaded = true; }
                    const int ll = it / 96, cbk = it % 96;
                    skinny_gemm(Al, red, INP(3) + (size_t)ll * 1024 * 6144, 6144, cbk * 64, WSP(float, WS_MOD) + (size_t)ll * 8 * 6144, 6144, INP(4) + (size_t)ll * 6144, tid);
                }
                __syncthreads();
            }
            {   LAS float* scr = (LAS float*)(lds + wave * 16640);
#pragma unroll 1
                for (int mi = 0; mi < 18; ++mi) {
                    const float* W; bf16_t* WT; int K, N;
                    if (mi < 2)       { W = INP(8) + (size_t)mi * 1024 * 1280; WT = WSP(bf16_t, WS_WHIN) + (size_t)mi * 1280 * 1024; K = 1024; N = 1280; }
                    else if (mi < 4)  { W = INP(21) + (size_t)(mi - 2) * 1024 * 1024; WT = WSP(bf16_t, WS_WHOUT) + (size_t)(mi - 2) * 1024 * 1024; K = 1024; N = 1024; }
                    else if (mi < 6)  { W = INP(17) + (size_t)(mi - 4) * 512 * 512; WT = WSP(bf16_t, WS_WGLU) + (size_t)(mi - 4) * 512 * 512; K = 512; N = 512; }
                    else if (mi < 8)  { W = INP(22) + (size_t)(mi - 6) * 1024 * 2048; WT = WSP(bf16_t, WS_WRIN) + (size_t)(mi - 6) * 2048 * 1024; K = 1024; N = 2048; }
                    else if (mi < 10) { W = INP(30) + (size_t)(mi - 8) * 1024 * 1024; WT = WSP(bf16_t, WS_WROUT) + (size_t)(mi - 8) * 1024 * 1024; K = 1024; N = 1024; }
                    else if (mi < 14) { W = INP(5) + (size_t)(mi - 10) * 1024 * 4096; WT = WSP(bf16_t, WS_W1) + (size_t)(mi - 10) * 4096 * 1024; K = 1024; N = 4096; }
                    else              { W = INP(6) + (size_t)(mi - 14) * 4096 * 1024; WT = WSP(bf16_t, WS_W2) + (size_t)(mi - 14) * 1024 * 4096; K = 4096; N = 1024; }
                    const int nit = (K / 64) * (N / 64);
                    if (G > 128) { if (bid < G - 64) for (int it = bid * NWAVES + wave; it < nit; it += (G - 64) * NWAVES) p0_transpose_item(W, K, N, WT, scr, it, lane); }
                    else for (int it = gw; it < nit; it += NGW) p0_transpose_item(W, K, N, WT, scr, it, lane);
                }
            }
    }
#pragma unroll 1
    for (int step = (ph_lo > 1 ? ph_lo : 1); step < ph_hi + NDUP; ++step) {
        if (step > ph_lo) { if (step == 1) grid.sync(); else xcd_barrier(xbar); }
        const int ph = (DUP_PH < 0 || step <= DUP_PH) ? step : (step <= DUP_PH + NDUP ? DUP_PH : step - NDUP);
        const int tid = otid(), lane = tid & 63, wave = __builtin_amdgcn_readfirstlane(tid >> 6);
        unsigned lb_ = 0; asm volatile("" : "+s"(lb_));
        LAS unsigned char* lds = lds0 + lb_; LAS u64* PTAB = (LAS u64*)(lds + PTAB_OFF); LAS u64* DESC = (LAS u64*)(lds + DESC_OFF);
        int G = gridDim.x, bid = blockIdx.x;
        asm volatile("" : "+s"(G), "+s"(bid));
        const int vcu = (G % 8 == 0) ? (bid % 8) * (G / 8) + bid / 8 : bid;
        const int gw = vcu * NWAVES + wave, NGW = G * NWAVES;
        u64 wsv_ = ldptr(PTAB, 32), outv_ = ldptr(PTAB, 31);
        asm volatile("" : "+s"(wsv_), "+s"(outv_));
        unsigned char* ws = (unsigned char*)wsv_;
        float* out = (float*)outv_;
        int kind, l = 0;
        if (ph == 0) kind = K_P0; else if (ph == 1) kind = K_P0B; else if (ph == NPHASE - 1) kind = K_FINAL;
        else { int q = ph - 2, sub; if (q < 8) { l = 0; sub = q; } else if (q < 13) { l = 1; sub = q - 8; } else if (q < 21) { l = 2; sub = q - 13; } else { l = 3; sub = q - 21; }
            if ((l & 1) == 0) kind = (sub == 0) ? K_INPROJ : (sub == 1) ? K_S5E : (sub == 2) ? K_ATTN : (sub == 3) ? K_S5Y : (sub == 4) ? K_GLU : (sub == 5) ? K_OUTPROJ : (sub == 6) ? K_MLP1 : K_MLP2;
            else kind = (sub == 0) ? K_INPROJ : (sub == 1) ? K_RGLRU : (sub == 2) ? K_OUTPROJ : (sub == 3) ? K_MLP1 : K_MLP2; }
        const int e = l >> 1;
        const bool even = (l & 1) == 0;

        if (kind == K_P0B) {
            {   const int nhere = (G == 256) ? 20 : 360;
                for (int it = bid; it < nhere; it += G) shw_item(it, PTAB, ws, lds, tid);
            }
            {   const float* x = INP(0); const float* norm_w = INP(2); const float* MOD = WSP(float, WS_MOD); bf16_t* HW = WSP(bf16_t, WS_HW); float* ROWSS = WSP(float, WS_ROWSS);
                for (int m0 = 2 * gw; m0 < MTOK; m0 += 2 * NGW) {
                    const int b = m0 >> 12;
                    f32x4 v[2][4];
#pragma unroll
                    for (int rr = 0; rr < 2; ++rr)
#pragma unroll
                        for (int j = 0; j < 4; ++j) v[rr][j] = ((const f32x4*)(x + (size_t)(m0 + rr) * DM) + lane)[64 * j];
#pragma unroll
                    for (int rr = 0; rr < 2; ++rr) { const int m = m0 + rr; float ss = 0.f;
#pragma unroll
                        for (int j = 0; j < 4; ++j) { const f32x4 vv = v[rr][j]; ss += (vv[0] * vv[0] + vv[1] * vv[1]) + (vv[2] * vv[2] + vv[3] * vv[3]);
                            const int col = 4 * lane + 256 * j;
                            const f32x4 nw = *(const f32x4*)(norm_w + col), sc = *(const f32x4*)(MOD + (size_t)b * 6144 + 1024 + col);
                            const f32x4 hw = vv * nw * (sc + 1.0f);
                            v2u w; w.x = cvt_pk_bf16(hw[0], hw[1]); w.y = cvt_pk_bf16(hw[2], hw[3]); *(v2u*)(HW + (size_t)m * DM + col) = w; }
                        ss = wave_sum(ss, lane);
                        if (lane < 16) ROWSS[(size_t)m * 16 + lane] = lane == 0 ? ss : 0.f; }
                }
            }
        } else if (kind == K_FINAL) {
            const float* final_w = INP(7); const float* ROWSS = WSP(float, WS_ROWSS);
            for (int m = gw; m < MTOK; m += NGW) {
                const float v = lane < 16 ? ROWSS[(size_t)m * 16 + lane] : 0.f;
                const float ss = wave_sum(v, lane);
                const float rstd = 1.0f / sqrtf(ss * (1.0f / 1024.0f) + 1e-6f);
                f32x4* orow = (f32x4*)(out + (size_t)m * DM) + lane;
#pragma unroll
                for (int j = 0; j < 4; ++j) { const f32x4 fw = *(const f32x4*)(final_w + 4 * lane + 256 * j); orow[64 * j] = orow[64 * j] * rstd * fw; }
            }
        } else if (kind == K_RGLRU) {
            rglru_phase(e, WSP(bf16_t, R_Z), WSP(bf16_t, R_HF), WSP(bf16_t, R_MIX), INP(23), INP(24), INP(25), INP(26), INP(27), INP(28), INP(29), lds, tid, bid, G);
        } else if (kind == K_ATTN) {
            s5_scan_phase(WSP(float, R_E), WSP(bf16_t, R_AP), WSP(f32x2, WS_A32) + e * 4096, lds, tid, bid, G);
            const attn_body::AttnTensors AT{(const attn_body::bf16*)WSP(bf16_t, R_Q), (const attn_body::bf16*)WSP(bf16_t, R_K), (const attn_body::bf16*)WSP(bf16_t, R_V), (attn_body::bf16*)(WSP(bf16_t, R_MIX) + 512)};
            const attn_body::StaticOrder SO(G, bid);
            attn_body::attn_phase<attn_body::StaticOrder>((char*)lds_raw + lb_, AT, SO);
        } else {
            pg8::Gemm g{}; pg8::Sched S{}; pg8::Epi E{};
            S.G = G; S.c = bid; S.mode = 0; S.nM = 128; E.d = DESC;
            const float* mod_l = WSP(float, WS_MOD) + (size_t)l * 8 * 6144;
            u64 dv[15];
#pragma unroll
            for (int i = 0; i < 15; ++i) dv[i] = 0;
            if (kind == K_INPROJ) {
                g.A = WSP(bf16_t, WS_HW); g.lda = 1024; g.K = 1024; g.perm = 1; g.ldb = 1024;
                dv[0] = (u64)WSP(float, WS_ROWSS); dv[1] = (u64)(WSP(float, WS_SHW1) + (size_t)l * 8 * 2048); dv[14] = 2048;
                if (even) { g.Bt = WSP(bf16_t, WS_WHIN) + (size_t)e * 1280 * 1024; S.nN = 5; E.mode = pg8::EM_INA; dv[2] = (u64)WSP(bf16_t, R_AP); dv[3] = (u64)WSP(bf16_t, R_Q); dv[4] = (u64)WSP(bf16_t, R_K); dv[5] = (u64)WSP(bf16_t, R_V); }
                else { g.Bt = WSP(bf16_t, WS_WRIN) + (size_t)e * 2048 * 1024; S.nN = 8; E.mode = pg8::EM_INB; dv[2] = (u64)WSP(bf16_t, R_Z); }
            } else if (kind == K_S5E) {
                g.A = WSP(bf16_t, R_AP); g.lda = 768; g.K = 512; g.perm = 0; g.Bt = WSP(bf16_t, WS_PT) + (size_t)e * PT_LAYER; g.ldb = 512;
                S.mode = 1; S.nN = 1; E.mode = pg8::EM_S5E; dv[6] = (u64)WSP(float, R_E);
            } else if (kind == K_S5Y) {
                g.A = WSP(bf16_t, R_AP); g.lda = 768; g.K = 768; g.perm = 1; g.Bt = WSP(bf16_t, WS_TT) + (size_t)e * TT_LAYER; g.ldb = 768;
                S.mode = 2; S.nN = 2; E.mode = pg8::EM_S5Y; dv[2] = (u64)WSP(bf16_t, R_G); dv[13] = (u64)WSP(bf16_t, R_AP); dv[12] = (u64)(INP(16) + e * 512);
            } else if (kind == K_GLU) {
                g.A = WSP(bf16_t, R_G); g.lda = 512; g.K = 512; g.perm = 1; g.Bt = WSP(bf16_t, WS_WGLU) + (size_t)e * 512 * 512; g.ldb = 512;
                S.nN = 2; E.mode = pg8::EM_GLU; dv[2] = (u64)WSP(bf16_t, R_MIX); dv[13] = (u64)WSP(bf16_t, R_G); dv[12] = (u64)(INP(18) + e * 512);
            } else if (kind == K_OUTPROJ) {
                g.A = WSP(bf16_t, R_MIX); g.lda = 1024; g.K = 1024; g.perm = 0; g.Bt = (even ? WSP(bf16_t, WS_WHOUT) : WSP(bf16_t, WS_WROUT)) + (size_t)e * 1024 * 1024; g.ldb = 1024;
                S.nN = 4; E.mode = pg8::EM_RES; dv[6] = (u64)out; dv[7] = (l == 0) ? (u64)INP(0) : (u64)out; dv[8] = (u64)(mod_l + 2048);
                dv[9] = (u64)(INP(2) + (size_t)(l * 2 + 1) * 1024); dv[10] = (u64)(mod_l + 4096); dv[2] = (u64)WSP(bf16_t, WS_HW); dv[11] = (u64)WSP(float, WS_ROWSS);
            } else if (kind == K_MLP1) {
                g.A = WSP(bf16_t, WS_HW); g.lda = 1024; g.K = 1024; g.perm = 1; g.Bt = WSP(bf16_t, WS_W1) + (size_t)l * 4096 * 1024; g.ldb = 1024;
                S.nN = 16; E.mode = pg8::EM_MLP1; dv[0] = (u64)WSP(float, WS_ROWSS); dv[1] = (u64)(WSP(float, WS_SHW2) + (size_t)l * 8 * 4096); dv[14] = 4096; dv[2] = (u64)WSP(bf16_t, R_HID);
            } else {
                g.A = WSP(bf16_t, R_HID); g.lda = 4096; g.K = 4096; g.perm = 0; g.Bt = WSP(bf16_t, WS_W2) + (size_t)l * 1024 * 4096; g.ldb = 4096;
                S.nN = 4; E.mode = pg8::EM_RES; dv[6] = (u64)out; dv[7] = (u64)out; dv[8] = (u64)(mod_l + 5120);
                if (l < 3) { dv[9] = (u64)(INP(2) + (size_t)((l + 1) * 2) * 1024); dv[10] = (u64)(WSP(float, WS_MOD) + (size_t)(l + 1) * 8 * 6144 + 1024); }
                dv[2] = (u64)WSP(bf16_t, WS_HW); dv[11] = (u64)WSP(float, WS_ROWSS);
            }
            __syncthreads();
            if (tid == 0) {
#pragma unroll
                for (int i = 0; i < 15; ++i) DESC[i] = dv[i];
            }
            __syncthreads();
            S.nwg = (S.mode == 1) ? 128 : (S.mode == 2 ? 256 : S.nM * S.nN);
            pg8::gemm_phase<pg8::Epi, pg8::Sched, true, true>(lds, g, S, E);
            if (G == 256 && l == 0 && bid >= 128) {
                if (kind == K_INPROJ) { shw_item(20 + (bid - 128), PTAB, ws, lds, tid); shw_item(148 + (bid - 128), PTAB, ws, lds, tid); }
                else if (kind == K_S5E && 276 + (bid - 128) < 360) shw_item(276 + (bid - 128), PTAB, ws, lds, tid);
            }
            if (kind == K_S5E) { __syncthreads(); qkprep_phase(WSP(bf16_t, R_Q), WSP(bf16_t, R_K), INP(19) + e * 64, INP(20) + e * 64, WSP(f32x2, WS_ROPE), lds, tid, gw, NGW); }
        }
    }
}

extern "C" void kernel_launch(void* const* d_in, const int* in_sizes, int n_in, void* d_out, int out_size, void* d_ws, size_t ws_size, hipStream_t stream) {
    static int grid = 0;
    if (grid == 0) {
        int dev = 0, cus = 0, per_cu = 0;
        (void)hipGetDevice(&dev); (void)hipDeviceGetAttribute(&cus, hipDeviceAttributeMultiprocessorCount, dev);
        (void)hipFuncSetAttribute((const void*)fwd_mega, hipFuncAttributeMaxDynamicSharedMemorySize, LDS_BYTES);
        (void)hipOccupancyMaxActiveBlocksPerMultiprocessor(&per_cu, (const void*)fwd_mega, NTHR, LDS_BYTES);
        if (per_cu < 1) per_cu = 1;
        (void)hipGetLastError();
        grid = cus * per_cu;
        if (ws_size < WS_END) fprintf(stderr, "kernel_launch: workspace too small: %zu < %zu\n", ws_size, (size_t)WS_END);
        if (n_in != 31) fprintf(stderr, "kernel_launch: expected 31 inputs, got %d\n", n_in);
    }
    (void)hipMemsetAsync(d_ws, 0, 16384, stream);
    Args a{};
    for (int i = 0; i < 31; ++i) a.in[i] = (const float*)d_in[i];
    a.out = (float*)d_out; a.ws = (unsigned char*)d_ws; a.ph_lo = 0; a.ph_hi = NPHASE;
    void* kargs[] = {&a};
    hipError_t err = hipLaunchCooperativeKernel((const void*)fwd_mega, dim3(grid), dim3(NTHR), kargs, LDS_BYTES, stream);
    if (err != hipSuccess) fprintf(stderr, "cooperative launch failed: %s (grid %d)\n", hipGetErrorString(err), grid);
}
```

```cpp
#include <hip/hip_runtime.h>
#include <hip/hip_bf16.h>
#include <hip/hip_cooperative_groups.h>
#include <cstdio>
#include <cstdint>
#include <cmath>
namespace cg = cooperative_groups;
__device__ __forceinline__ int otid() { int t = threadIdx.x; asm volatile("" : "+v"(t)); return t; }
__device__ __forceinline__ float shx(float v, int mask, int lane) { return __builtin_bit_cast(float, __builtin_amdgcn_ds_bpermute((lane ^ mask) << 2, __builtin_bit_cast(int, v))); }
namespace pg8 {
#define PG8_LAS __attribute__((address_space(3)))
typedef unsigned short bf16_t;
typedef short bf16x8 __attribute__((ext_vector_type(8)));
typedef float f32x4 __attribute__((ext_vector_type(4)));
typedef unsigned u32x4 __attribute__((ext_vector_type(4)));
constexpr int BM = 256, BK = 64, HALF = 128, HTB = HALF * BK * 2  , STAGE_BYTES = 8 * HTB, NXCD = 8, WGM = 4;

__host__ __device__ __forceinline__ int lds_byte(int r, int c) { const int st = (r >> 4) * 2 + (c >> 5), rr = r & 15, cc = c & 31, ob = rr * 64 + cc * 2; return st * 1024 + (ob ^ (((ob >> 9) & 1) << 5)); }
__host__ __device__ __forceinline__ void stage_rc(int b, int& R, int& C) { const int st = b / 1024, sb = b % 1024, swz = sb ^ (((sb >> 9) & 1) << 5); R = (st >> 1) * 16 + swz / 64; C = (st & 1) * 32 + (swz % 64) / 2; }
__host__ __device__ __forceinline__ int perm32(int rho) { const int n = rho >> 4, i = rho & 15; return 8 * (i >> 2) + 4 * n + (i & 3); }

struct Unit { int pm, pn; };
typedef unsigned u32x2 __attribute__((ext_vector_type(2)));
}
namespace pg8 {
struct Gemm { const bf16_t* A; const bf16_t* Bt; int lda, ldb, K, perm; };
__device__ __forceinline__ unsigned cvt_pk_bf16(float lo, float hi) { unsigned r; asm("v_cvt_pk_bf16_f32 %0, %1, %2" : "=v"(r) : "v"(lo), "v"(hi)); return r; }
__device__ __forceinline__ float bflo(unsigned w) { return __uint_as_float(w << 16); }
__device__ __forceinline__ float bfhi(unsigned w) { return __uint_as_float(w & 0xffff0000u); }
__device__ __forceinline__ float gelu_tanh(float x) { return x * __builtin_amdgcn_rcpf(1.0f + __builtin_amdgcn_exp2f(x * (-2.3022082f + -0.10294324f * x * x))); }
__device__ __forceinline__ float sigmoidf_(float x) { return __builtin_amdgcn_rcpf(1.0f + __builtin_amdgcn_exp2f(-1.4426950408889634f * x)); }

struct Sched { int mode, nM, nN, nwg, G, c;
    __device__ __forceinline__ bool next(int i, Unit& u) const {
        const long L = (long)i * G + c; if (L >= nwg) return false;
        if (mode == 0) {
            int wgid = (int)L; { const int q = nwg / NXCD, r = nwg % NXCD, xcd = wgid % NXCD, off = wgid / NXCD; wgid = (xcd < r ? xcd * (q + 1) : r * (q + 1) + (xcd - r) * q) + off; }
            const int nig = WGM * nN, gid = wgid / nig, fm = gid * WGM, gsz = (nM - fm) < WGM ? (nM - fm) : WGM;
            u.pm = fm + ((wgid % nig) % gsz); u.pn = (wgid % nig) / gsz;
        } else if (mode == 1) { u.pm = (int)L; u.pn = (int)L >> 2; }
        else if (mode == 3) { u.pm = (int)L - 128; u.pn = 4; }
        else { u.pm = (int)L >> 1; u.pn = (((int)L >> 3) << 1) + ((int)L & 1); }
        return true;
    }
    __device__ __forceinline__ void a_ready(const Unit&) const {}
    __device__ __forceinline__ void done(const Unit&) const {}
};

enum { EM_INA = 0, EM_INB = 1, EM_MLP1 = 2, EM_S5E = 3, EM_S5Y = 4, EM_GLU = 5, EM_RES = 6 };
struct Epi {
    static constexpr bool AFTER_DRAIN = false;
    int mode; const PG8_LAS unsigned long long* d;
    __device__ __forceinline__ unsigned long long P(int i) const { const unsigned long long v = d[i]; const unsigned lo = __builtin_amdgcn_readfirstlane((unsigned)v), hi = __builtin_amdgcn_readfirstlane((unsigned)(v >> 32)); return ((unsigned long long)hi << 32) | lo; }
    __device__ __forceinline__ void operator()(const f32x4 (&acc)[2][2][4][2], const Unit& u, int wr, int wc, int fr, int fq) const {
        if (mode <= EM_MLP1) {
            const float* rowss = (const float*)P(0); const float* shw = (const float*)P(1); const int ldshw = (int)P(14); bf16_t* o0 = (bf16_t*)P(2); bf16_t* o1 = (bf16_t*)P(3); bf16_t* o2 = (bf16_t*)P(4); bf16_t* o3 = (bf16_t*)P(5);
            const int bb = u.pm >> 4;
            const int colt = u.pn * BM + wc * 32 + 8 * fq;
            f32x4 sv[2][2];
#pragma unroll
            for (int bj = 0; bj < 2; ++bj)
#pragma unroll
                for (int n = 0; n < 2; ++n) sv[bj][n] = *(const f32x4*)(shw + (size_t)bb * ldshw + colt + bj * HALF + 4 * n);
            f32x4 pr[2][4];
#pragma unroll
            for (int ai = 0; ai < 2; ++ai)
#pragma unroll
                for (int m = 0; m < 4; ++m) pr[ai][m] = *((const f32x4*)(rowss + (size_t)(u.pm * BM + ai * HALF + wr * 64 + m * 16 + fr) * 16) + fq);
            float rsd[2][4];
#pragma unroll
            for (int ai = 0; ai < 2; ++ai)
#pragma unroll
                for (int m = 0; m < 4; ++m) { float ss = (pr[ai][m][0] + pr[ai][m][1]) + (pr[ai][m][2] + pr[ai][m][3]); ss += shx(ss, 16, fr + 16 * fq); ss += shx(ss, 32, fr + 16 * fq);
                    rsd[ai][m] = __builtin_amdgcn_rsqf(ss * (1.0f / 1024.0f) + 1e-6f); }
#pragma unroll
            for (int ai = 0; ai < 2; ++ai)
#pragma unroll
                for (int m = 0; m < 4; ++m) {
                    const int row = u.pm * BM + ai * HALF + wr * 64 + m * 16 + fr;
                    const float rstd = rsd[ai][m];
#pragma unroll
                    for (int bj = 0; bj < 2; ++bj) {
                        f32x4 v0 = acc[ai][bj][m][0] * rstd + sv[bj][0], v1 = acc[ai][bj][m][1] * rstd + sv[bj][1];
                        const int col = colt + bj * HALF;
                        bf16_t* dst;
                        if (mode == EM_MLP1) {
#pragma unroll
                            for (int j = 0; j < 4; ++j) { const float a = fmaxf(v0[j], 0.f), b = fmaxf(v1[j], 0.f); v0[j] = a * a; v1[j] = b * b; }
                            dst = o0 + (size_t)row * 4096 + col;
                        } else if (mode == EM_INB) { dst = o0 + (size_t)row * 2048 + col; }
                        else {
                            if (u.pn < 2) { const int g = col >> 4, c0 = col & 15, s = row & 4095; dst = o0 + ((size_t)(g * 1024 + bb * 128 + (s >> 5)) * 768 + (s & 31) * 16 + c0); }
                            else if (u.pn < 4) dst = o1 + (size_t)row * 512 + (col - 512);
                            else if (bj == 0) dst = o2 + (size_t)row * 128 + (col - 1024);
                            else dst = o3 + (size_t)row * 128 + (col - 1152);
                        }
                        u32x4 w; w.x = cvt_pk_bf16(v0[0], v0[1]); w.y = cvt_pk_bf16(v0[2], v0[3]); w.z = cvt_pk_bf16(v1[0], v1[1]); w.w = cvt_pk_bf16(v1[2], v1[3]);
                        *(u32x4*)dst = w;
                    }
                }
        } else if (mode == EM_S5E) {
            float* of = (float*)P(6);
#pragma unroll
            for (int ai = 0; ai < 2; ++ai)
#pragma unroll
                for (int m = 0; m < 4; ++m) {
                    const int row = u.pm * BM + ai * HALF + wr * 64 + m * 16 + fr;
#pragma unroll
                    for (int bj = 0; bj < 2; ++bj)
#pragma unroll
                        for (int n = 0; n < 2; ++n) *(f32x4*)(of + (size_t)row * 256 + bj * HALF + wc * 32 + n * 16 + 4 * fq) = acc[ai][bj][m][n];
                }
        } else if (mode == EM_S5Y) {
            const float* vec = (const float*)P(12); const bf16_t* gin = (const bf16_t*)P(13); bf16_t* o0 = (bf16_t*)P(2);
            const int g = u.pn >> 1, pnl = u.pn & 1;
            const int c0 = 8 * (fq & 1);
            const f32x4 d0 = *(const f32x4*)(vec + g * 16 + c0), d1 = *(const f32x4*)(vec + g * 16 + c0 + 4);
#pragma unroll
            for (int ai = 0; ai < 2; ++ai) {
                u32x4 ua[2][4][2];
#pragma unroll
                for (int m = 0; m < 4; ++m)
#pragma unroll
                    for (int bj = 0; bj < 2; ++bj) ua[ai][m][bj] = *(const u32x4*)(gin + (size_t)(u.pm * BM + ai * HALF + wr * 64 + m * 16 + fr) * 768 + ((pnl * BM + bj * HALF + wc * 32 + 8 * fq) >> 4) * 16 + c0);
                asm volatile("" ::: "memory");
#pragma unroll
                for (int m = 0; m < 4; ++m) {
                    const int row = u.pm * BM + ai * HALF + wr * 64 + m * 16 + fr;
                    const int rg = row & 1023, b = rg >> 7, k = rg & 127;
#pragma unroll
                    for (int bj = 0; bj < 2; ++bj) {
                        const int nn = pnl * BM + bj * HALF + wc * 32 + 8 * fq, tl = nn >> 4;
                        const u32x4 uu = ua[ai][m][bj];
                        f32x4 v0 = acc[ai][bj][m][0], v1 = acc[ai][bj][m][1];
                        v0[0] += d0[0] * bflo(uu.x); v0[1] += d0[1] * bfhi(uu.x); v0[2] += d0[2] * bflo(uu.y); v0[3] += d0[3] * bfhi(uu.y);
                        v1[0] += d1[0] * bflo(uu.z); v1[1] += d1[1] * bfhi(uu.z); v1[2] += d1[2] * bflo(uu.w); v1[3] += d1[3] * bfhi(uu.w);
#pragma unroll
                        for (int j = 0; j < 4; ++j) { v0[j] = gelu_tanh(v0[j]); v1[j] = gelu_tanh(v1[j]); }
                        u32x4 w; w.x = cvt_pk_bf16(v0[0], v0[1]); w.y = cvt_pk_bf16(v0[2], v0[3]); w.z = cvt_pk_bf16(v1[0], v1[1]); w.w = cvt_pk_bf16(v1[2], v1[3]);
                        const size_t token = (size_t)b * 4096 + k * 32 + tl;
                        *(u32x4*)(o0 + token * 512 + g * 16 + c0) = w;
                    }
                }
            }
        } else if (mode == EM_GLU) {
            const float* vec = (const float*)P(12); const bf16_t* gin = (const bf16_t*)P(13); bf16_t* o0 = (bf16_t*)P(2);
            const int colt = u.pn * BM + wc * 32 + 8 * fq;
            f32x4 bv[2][2];
#pragma unroll
            for (int bj = 0; bj < 2; ++bj)
#pragma unroll
                for (int n = 0; n < 2; ++n) bv[bj][n] = *(const f32x4*)(vec + colt + bj * HALF + 4 * n);
#pragma unroll
            for (int ai = 0; ai < 2; ++ai) {
                u32x4 ga[2][4][2];
#pragma unroll
                for (int m = 0; m < 4; ++m)
#pragma unroll
                    for (int bj = 0; bj < 2; ++bj) ga[ai][m][bj] = *(const u32x4*)(gin + (size_t)(u.pm * BM + ai * HALF + wr * 64 + m * 16 + fr) * 512 + colt + bj * HALF);
                asm volatile("" ::: "memory");
#pragma unroll
                for (int m = 0; m < 4; ++m) {
                    const int row = u.pm * BM + ai * HALF + wr * 64 + m * 16 + fr;
#pragma unroll
                    for (int bj = 0; bj < 2; ++bj) {
                        const int col = colt + bj * HALF;
                        const u32x4 gg = ga[ai][m][bj];
                        f32x4 v0 = acc[ai][bj][m][0] + bv[bj][0], v1 = acc[ai][bj][m][1] + bv[bj][1];
                        v0[0] = bflo(gg.x) * sigmoidf_(v0[0]); v0[1] = bfhi(gg.x) * sigmoidf_(v0[1]); v0[2] = bflo(gg.y) * sigmoidf_(v0[2]); v0[3] = bfhi(gg.y) * sigmoidf_(v0[3]);
                        v1[0] = bflo(gg.z) * sigmoidf_(v1[0]); v1[1] = bfhi(gg.z) * sigmoidf_(v1[1]); v1[2] = bflo(gg.w) * sigmoidf_(v1[2]); v1[3] = bfhi(gg.w) * sigmoidf_(v1[3]);
                        u32x4 w; w.x = cvt_pk_bf16(v0[0], v0[1]); w.y = cvt_pk_bf16(v0[2], v0[3]); w.z = cvt_pk_bf16(v1[0], v1[1]); w.w = cvt_pk_bf16(v1[2], v1[3]);
                        *(u32x4*)(o0 + (size_t)row * 1024 + col) = w;
                    }
                }
            }
        } else {
            bf16_t* oh = (bf16_t*)P(6); const void* hin = (const void*)P(7); const float* gate = (const float*)P(8); const float* nw = (const float*)P(9); const float* nsc = (const float*)P(10); float* rowss_out = (float*)P(11); bf16_t* o0 = (bf16_t*)P(2);
            const bool hin32 = P(15) != 0;
            const int bb = u.pm >> 4;
            const int colt = u.pn * BM + wc * 32 + 8 * fq;
            f32x4 gv[2][2], wv[2][2];
#pragma unroll
            for (int bj = 0; bj < 2; ++bj)
#pragma unroll
                for (int n = 0; n < 2; ++n) { const int col = colt + bj * HALF + 4 * n;
                    gv[bj][n] = *(const f32x4*)(gate + (size_t)bb * 6144 + col);
                    if (nw) { const f32x4 a = *(const f32x4*)(nw + col), sc = *(const f32x4*)(nsc + (size_t)bb * 6144 + col); wv[bj][n] = a * (sc + 1.0f); } else wv[bj][n] = (f32x4){0.f, 0.f, 0.f, 0.f}; }
#pragma unroll
            for (int am = 0; am < 4; ++am) { const int ai = am >> 1, m0 = 2 * (am & 1);
#define RES_ROW(H0, H1) do { \
                    const int row = u.pm * BM + ai * HALF + wr * 64 + m * 16 + fr; const size_t off = (size_t)row * 1024 + colt + bj * HALF; \
                    const f32x4 h0 = (H0) + gv[bj][0] * acc[ai][bj][m][0], h1 = (H1) + gv[bj][1] * acc[ai][bj][m][1]; \
                    u32x4 w; w.x = cvt_pk_bf16(h0[0], h0[1]); w.y = cvt_pk_bf16(h0[2], h0[3]); w.z = cvt_pk_bf16(h1[0], h1[1]); w.w = cvt_pk_bf16(h1[2], h1[3]); \
                    *(u32x4*)(oh + off) = w; \
                    const f32x4 q0 = (f32x4){bflo(w.x), bfhi(w.x), bflo(w.y), bfhi(w.y)}, q1 = (f32x4){bflo(w.z), bfhi(w.z), bflo(w.w), bfhi(w.w)}; \
                    sq[m - m0] += ((q0[0] * q0[0] + q0[1] * q0[1]) + (q0[2] * q0[2] + q0[3] * q0[3])) + ((q1[0] * q1[0] + q1[1] * q1[1]) + (q1[2] * q1[2] + q1[3] * q1[3])); \
                    if (nw) { const f32x4 a0 = q0 * wv[bj][0], a1 = q1 * wv[bj][1]; u32x4 v; v.x = cvt_pk_bf16(a0[0], a0[1]); v.y = cvt_pk_bf16(a0[2], a0[3]); v.z = cvt_pk_bf16(a1[0], a1[1]); v.w = cvt_pk_bf16(a1[2], a1[3]); *(u32x4*)(o0 + off) = v; } } while (0)
                float sq[2] = {0.f, 0.f};
                if (hin32) {
                    f32x4 ha[2][2][2];
#pragma unroll
                    for (int m = m0; m < m0 + 2; ++m)
#pragma unroll
                        for (int bj = 0; bj < 2; ++bj)
#pragma unroll
                            for (int n = 0; n < 2; ++n) ha[m - m0][bj][n] = *(const f32x4*)((const float*)hin + (size_t)(u.pm * BM + ai * HALF + wr * 64 + m * 16 + fr) * 1024 + colt + bj * HALF + 4 * n);
                    asm volatile("" ::: "memory");
#pragma unroll
                    for (int m = m0; m < m0 + 2; ++m)
#pragma unroll
                        for (int bj = 0; bj < 2; ++bj) RES_ROW(ha[m - m0][bj][0], ha[m - m0][bj][1]);
                } else {
                    u32x4 hr[2][2];
#pragma unroll
                    for (int m = m0; m < m0 + 2; ++m)
#pragma unroll
                        for (int bj = 0; bj < 2; ++bj) hr[m - m0][bj] = *(const u32x4*)((const bf16_t*)hin + (size_t)(u.pm * BM + ai * HALF + wr * 64 + m * 16 + fr) * 1024 + colt + bj * HALF);
                    asm volatile("" ::: "memory");
#pragma unroll
                    for (int m = m0; m < m0 + 2; ++m)
#pragma unroll
                        for (int bj = 0; bj < 2; ++bj) { const u32x4 x = hr[m - m0][bj]; RES_ROW(((f32x4){bflo(x.x), bfhi(x.x), bflo(x.y), bfhi(x.y)}), ((f32x4){bflo(x.z), bfhi(x.z), bflo(x.w), bfhi(x.w)})); }
                }
#undef RES_ROW
#pragma unroll
                for (int m = m0; m < m0 + 2; ++m) { float t = sq[m - m0]; t += shx(t, 16, fr + 16 * fq); t += shx(t, 32, fr + 16 * fq);
                    if (fq == 0) rowss_out[(size_t)(u.pm * BM + ai * HALF + wr * 64 + m * 16 + fr) * 16 + u.pn * 4 + wc] = t; }
            }
        }
    }
};
}
namespace pg8 {
template <class Epi, class Sched, bool ALIGN_EPI = false, bool SP2 = false>
__device__ __forceinline__ void gemm_phase(PG8_LAS unsigned char* lds, const Gemm g, const Sched& S, const Epi& E) {
    const int tid = otid(), wid = __builtin_amdgcn_readfirstlane(tid >> 6), lane = tid & 63, wr = wid >> 2, wc = wid & 3, fr = lane & 15, fq = lane >> 4;
    const int K = g.K, nt = K / BK;
    unsigned voffA[2], voffB[2];
#pragma unroll
    for (int i = 0; i < 2; ++i) { int R, C; stage_rc(tid * 16 + i * 8192, R, C); const int Rb = g.perm ? ((R & ~31) + perm32(R & 31)) : R;
        voffA[i] = (unsigned)(R * g.lda + C) * 2u; voffB[i] = (unsigned)(Rb * g.ldb + C) * 2u; }
    const size_t kstep = (size_t)(BK * 2);
    const size_t hstepA = (size_t)HALF * g.lda * 2, hstepB = (size_t)HALF * g.ldb * 2;
    const size_t tstepA = 2 * hstepA, tstepB = 2 * hstepB;
    const unsigned ldsw = (unsigned)wid * 1024u;
    const int aoff = lds_byte(wr * 64 + fr, fq * 8), boff = lds_byte(wc * 32 + fr, fq * 8);
#define PG8_SA(b, h) (((b) * 2 + (h)) * HTB)
#define PG8_SB(b, h) ((4 + (b) * 2 + (h)) * HTB)
#define PG8_STAGE(bufoff, gbase, voff) do { _Pragma("unroll") for (int _i = 0; _i < 2; ++_i) \
        __builtin_amdgcn_global_load_lds((const unsigned*)((const char*)(gbase) + (voff)[_i]), (PG8_LAS unsigned*)(lds + (bufoff) + ldsw + _i * 8192), 16, 0, 0); } while (0)
#define PG8_LDA(dst, b, h) do { _Pragma("unroll") for (int m = 0; m < 4; ++m) _Pragma("unroll") for (int k = 0; k < 2; ++k) dst[m][k] = *(const PG8_LAS bf16x8*)(lds + PG8_SA(b, h) + aoff + m * 2048 + k * 1024); } while (0)
#define PG8_LDB(dst, b, h) do { _Pragma("unroll") for (int n = 0; n < 2; ++n) _Pragma("unroll") for (int k = 0; k < 2; ++k) dst[n][k] = *(const PG8_LAS bf16x8*)(lds + PG8_SB(b, h) + boff + n * 2048 + k * 1024); } while (0)
#define PG8_MMA(ai, bj, At, Bt) do { __builtin_amdgcn_s_setprio(1); _Pragma("unroll") for (int m = 0; m < 4; ++m) _Pragma("unroll") for (int n = 0; n < 2; ++n) _Pragma("unroll") for (int k = 0; k < 2; ++k) \
        acc[ai][bj][m][n] = __builtin_amdgcn_mfma_f32_16x16x32_bf16(Bt[n][k], At[m][k], acc[ai][bj][m][n], 0, 0, 0); __builtin_amdgcn_s_setprio(0); } while (0)
#define PG8_WAIT_V(n) asm volatile("s_waitcnt vmcnt(" #n ")" ::: "memory")
#define PG8_WAIT_L(n) asm volatile("s_waitcnt lgkmcnt(" #n ")" ::: "memory")
#define PG8_BAR __builtin_amdgcn_s_barrier()
#define PG8_SCHED __builtin_amdgcn_sched_barrier(0)
    Unit cur, nxt; int ui = 0;
    if (!S.next(0, cur)) return;
    f32x4 acc[2][2][4][2];
#pragma unroll
    for (int a = 0; a < 2; ++a)
#pragma unroll
        for (int b = 0; b < 2; ++b)
#pragma unroll
            for (int m = 0; m < 4; ++m)
#pragma unroll
                for (int n = 0; n < 2; ++n) acc[a][b][m][n] = (f32x4){0.f, 0.f, 0.f, 0.f};
    bf16x8 At[4][2], B0[2][2], B1[2][2];
    const char* cA = (const char*)g.A + (size_t)cur.pm * tstepA; const char* cB = (const char*)g.Bt + (size_t)cur.pn * tstepB;
    S.a_ready(cur);
    if constexpr (SP2) {
        PG8_STAGE(PG8_SB(0, 0), cB, voffB); PG8_STAGE(PG8_SB(0, 1), cB + hstepB, voffB); PG8_STAGE(PG8_SA(0, 0), cA, voffA); PG8_STAGE(PG8_SA(0, 1), cA + hstepA, voffA);
        if (wr == 1) PG8_BAR;
        PG8_WAIT_V(2); PG8_BAR;
        PG8_STAGE(PG8_SB(1, 0), cB + kstep, voffB); PG8_STAGE(PG8_SA(1, 0), cA + kstep, voffA); PG8_STAGE(PG8_SB(1, 1), cB + hstepB + kstep, voffB);
        PG8_WAIT_V(6); PG8_BAR;
    } else {
        PG8_STAGE(PG8_SB(0, 0), cB, voffB); PG8_STAGE(PG8_SA(0, 0), cA, voffA); PG8_STAGE(PG8_SB(0, 1), cB + hstepB, voffB); PG8_STAGE(PG8_SA(0, 1), cA + hstepA, voffA);
        if (wr == 1) PG8_BAR;
        PG8_WAIT_V(4); PG8_BAR;
        PG8_STAGE(PG8_SB(1, 0), cB + kstep, voffB); PG8_STAGE(PG8_SA(1, 0), cA + kstep, voffA); PG8_STAGE(PG8_SB(1, 1), cB + hstepB + kstep, voffB);
        PG8_WAIT_V(6); PG8_BAR;
    }
    for (;;) {
        const bool has_next = S.next(ui + 1, nxt);
        const char* nA = has_next ? (const char*)g.A + (size_t)nxt.pm * tstepA : cA; const char* nB = has_next ? (const char*)g.Bt + (size_t)nxt.pn * tstepB : cB;
        for (int t = 0; t < nt; t += 2) {
            const bool last = (t == nt - 2);
            const char* a1 = cA + (size_t)(t + 1) * kstep;
            const char* a2 = last ? nA : cA + (size_t)(t + 2) * kstep; const char* b2 = last ? nB : cB + (size_t)(t + 2) * kstep;
            const char* a3 = a2 + kstep; const char* b3 = b2 + kstep;
            if (last && has_next) S.a_ready(nxt);
            if constexpr (SP2) {
            PG8_LDB(B0, 0, 0); PG8_LDB(B1, 0, 1); PG8_SCHED; PG8_LDA(At, 0, 0); PG8_STAGE(PG8_SA(1, 1), a1 + hstepA, voffA);
            PG8_WAIT_V(8); PG8_WAIT_L(0); PG8_BAR; PG8_MMA(0, 0, At, B0); PG8_MMA(0, 1, At, B1); PG8_BAR; PG8_SCHED;
            PG8_LDA(At, 0, 1); PG8_STAGE(PG8_SB(0, 0), b2, voffB); PG8_STAGE(PG8_SB(0, 1), b2 + hstepB, voffB); PG8_STAGE(PG8_SA(0, 0), a2, voffA);
            PG8_WAIT_V(8); PG8_WAIT_L(0); PG8_BAR; PG8_MMA(1, 0, At, B0); PG8_MMA(1, 1, At, B1); PG8_BAR; PG8_SCHED;
            PG8_LDB(B0, 1, 0); PG8_LDB(B1, 1, 1); PG8_SCHED; PG8_LDA(At, 1, 0); PG8_STAGE(PG8_SA(0, 1), a2 + hstepA, voffA);
            PG8_WAIT_V(8); PG8_WAIT_L(0); PG8_BAR; PG8_MMA(0, 0, At, B0); PG8_MMA(0, 1, At, B1); PG8_BAR; PG8_SCHED;
            PG8_LDA(At, 1, 1); PG8_STAGE(PG8_SB(1, 0), b3, voffB); PG8_STAGE(PG8_SB(1, 1), b3 + hstepB, voffB); PG8_STAGE(PG8_SA(1, 0), a3, voffA);
            PG8_WAIT_V(8); PG8_WAIT_L(0); PG8_BAR; PG8_MMA(1, 0, At, B0); PG8_MMA(1, 1, At, B1); PG8_BAR; PG8_SCHED;
            } else {
            PG8_LDB(B0, 0, 0); PG8_SCHED; PG8_LDA(At, 0, 0); PG8_STAGE(PG8_SA(1, 1), a1 + hstepA, voffA);
            PG8_WAIT_L(8); PG8_BAR; PG8_WAIT_L(0); PG8_MMA(0, 0, At, B0); PG8_BAR; PG8_SCHED;
            PG8_LDB(B1, 0, 1); PG8_STAGE(PG8_SB(0, 0), b2, voffB);
            PG8_BAR; PG8_WAIT_L(0); PG8_MMA(0, 1, At, B1); PG8_BAR;
            PG8_LDA(At, 0, 1); PG8_STAGE(PG8_SA(0, 0), a2, voffA);
            PG8_BAR; PG8_WAIT_L(0); PG8_MMA(1, 0, At, B0); PG8_BAR; PG8_SCHED;
            PG8_STAGE(PG8_SB(0, 1), b2 + hstepB, voffB);
            PG8_WAIT_V(6); PG8_BAR; PG8_MMA(1, 1, At, B1); PG8_BAR;
            PG8_LDB(B0, 1, 0); PG8_SCHED; PG8_LDA(At, 1, 0); PG8_STAGE(PG8_SA(0, 1), a2 + hstepA, voffA);
            PG8_WAIT_L(8); PG8_BAR; PG8_WAIT_L(0); PG8_MMA(0, 0, At, B0); PG8_BAR; PG8_SCHED;
            PG8_LDB(B1, 1, 1); PG8_STAGE(PG8_SB(1, 0), b3, voffB);
            PG8_BAR; PG8_WAIT_L(0); PG8_MMA(0, 1, At, B1); PG8_BAR;
            PG8_LDA(At, 1, 1); PG8_STAGE(PG8_SA(1, 0), a3, voffA);
            PG8_BAR; PG8_WAIT_L(0); PG8_MMA(1, 0, At, B0); PG8_BAR; PG8_SCHED;
            PG8_STAGE(PG8_SB(1, 1), b3 + hstepB, voffB);
            PG8_WAIT_V(6); PG8_BAR; PG8_MMA(1, 1, At, B1); PG8_BAR;
            }
        }
        if constexpr (ALIGN_EPI) { if (wr == 0) PG8_BAR; }
        if constexpr (!Epi::AFTER_DRAIN) { E(acc, cur, wr, wc, fr, fq); S.done(cur); }
        if (!has_next) break;
#pragma unroll
        for (int a = 0; a < 2; ++a)
#pragma unroll
            for (int b = 0; b < 2; ++b)
#pragma unroll
                for (int m = 0; m < 4; ++m)
#pragma unroll
                    for (int n = 0; n < 2; ++n) acc[a][b][m][n] = (f32x4){0.f, 0.f, 0.f, 0.f};
        cur = nxt; cA = nA; cB = nB; ++ui;
        if constexpr (ALIGN_EPI) { if (wr == 1) PG8_BAR; }
    }
    PG8_WAIT_V(0);
    if constexpr (!ALIGN_EPI) { if (wr == 0) PG8_BAR; }
    PG8_BAR;
    if constexpr (Epi::AFTER_DRAIN) { E.fused(acc, cur, wr, wc, fr, fq, lds, wid, lane); S.done(cur); }
#undef PG8_SA
#undef PG8_SB
#undef PG8_STAGE
#undef PG8_LDA
#undef PG8_LDB
#undef PG8_MMA
#undef PG8_WAIT_V
#undef PG8_WAIT_L
#undef PG8_BAR
#undef PG8_SCHED
}
}
#include <hip/hip_bf16.h>
#include <cmath>
namespace attn_body {
using bf16=__hip_bfloat16;
using bf16x8=__attribute__((ext_vector_type(8)))short;
using s16x4=__attribute__((ext_vector_type(4)))short;
using f32x16=__attribute__((ext_vector_type(16)))float;
using u32x4=__attribute__((ext_vector_type(4)))unsigned;
constexpr int BATCH=8,NHEAD=8,SEQ=4096,D=64,QP=512,KP=128,OP=1024;
constexpr int NW=8,QBLK=32,QB=QBLK*NW,KVBLK=64,NQB=SEQ/QB;
constexpr int ATTN_UNIT_ROWS=QB;
__device__ __forceinline__ int crow(int r,int hi){return (r&3)+8*(r>>2)+4*hi;}
#define SBAR() __builtin_amdgcn_sched_barrier(0)
__device__ __forceinline__ void cmask(f32x16&p0,f32x16&p1,int jb,int qrel,int hi){
  const float NEG=-INFINITY; int kb=64*jb+4*hi;
  #pragma unroll
  for(int r=0;r<16;++r){int kv=kb+(r&3)+8*(r>>2); if(kv>qrel)p0[r]=NEG; if(kv+32>qrel)p1[r]=NEG;}
}

constexpr int NSLOT=3, SLOTB=8192;
constexpr int LDS_K=0, LDS_V=NSLOT*SLOTB, LDS_WS=2*NSLOT*SLOTB, LDS_OST=LDS_WS+NW*64*4, LDS_BYTES=LDS_OST+NW*4096;
constexpr float C2=0.125f*1.4426950408889634f;
__device__ __forceinline__ void glds16(const void*gsrc,unsigned lds_dst){unsigned keep;
  asm volatile("s_mov_b32 %0, m0\n\ts_mov_b32 m0, %2\n\ts_nop 0\n\tglobal_load_lds_dwordx4 %1, off\n\ts_mov_b32 m0, %0":"=&s"(keep):"v"(gsrc),"s"(lds_dst):"memory");}
__device__ __forceinline__ float max3f(float a,float b,float c){float r;asm("v_max3_f32 %0, %1, %2, %3":"=v"(r):"v"(a),"v"(b),"v"(c));return r;}
__device__ __forceinline__ float max2f(float a,float b){float r;asm("v_max_f32_e32 %0, %1, %2":"=v"(r):"v"(a),"v"(b));return r;}
__device__ __forceinline__ float fadd_s(float a,float b){float r;asm("v_add_f32_e32 %0, %1, %2":"=v"(r):"v"(a),"v"(b));return r;}
__device__ __forceinline__ float fsub_s(float a,float b){float r;asm("v_sub_f32_e32 %0, %1, %2":"=v"(r):"v"(a),"v"(b));return r;}
typedef float f32x2_t __attribute__((ext_vector_type(2))); typedef __bf16 bf16x2_t __attribute__((ext_vector_type(2)));
__device__ __forceinline__ unsigned cvtpk_s(float lo,float hi){f32x2_t v={lo,hi};bf16x2_t b=__builtin_convertvector(v,bf16x2_t);return __builtin_bit_cast(unsigned,b);}
#define WAIT_BAR(N) asm volatile("s_waitcnt vmcnt(" #N ") lgkmcnt(0)\n\ts_barrier":::"memory")

__device__ __forceinline__ void qkt(f32x16&p0,f32x16&p1,const char*Kslot,const bf16x8*qr,const f32x16&negm,int r32,int hi){
  const char*kb=Kslot+hi*1024+r32*16;
  #pragma unroll
  for(int d0=0;d0<4;++d0){
    const bf16x8 b0=*reinterpret_cast<const bf16x8*>(kb+d0*2048);
    const bf16x8 b1=*reinterpret_cast<const bf16x8*>(kb+d0*2048+512);
    if(d0==0){p0=__builtin_amdgcn_mfma_f32_32x32x16_bf16(b0,qr[0],negm,0,0,0);p1=__builtin_amdgcn_mfma_f32_32x32x16_bf16(b1,qr[0],negm,0,0,0);}
    else{p0=__builtin_amdgcn_mfma_f32_32x32x16_bf16(b0,qr[d0],p0,0,0,0);p1=__builtin_amdgcn_mfma_f32_32x32x16_bf16(b1,qr[d0],p1,0,0,0);}}
}
typedef __attribute__((address_space(3))) const char* lds_cptr;
typedef short v4i16_t __attribute__((ext_vector_type(4)));
__device__ __forceinline__ void kload8(bf16x8*kf,lds_cptr kp){
  kf[0]=*(const __attribute__((address_space(3))) bf16x8*)(kp);      kf[1]=*(const __attribute__((address_space(3))) bf16x8*)(kp+512);
  kf[2]=*(const __attribute__((address_space(3))) bf16x8*)(kp+2048); kf[3]=*(const __attribute__((address_space(3))) bf16x8*)(kp+2560);
  kf[4]=*(const __attribute__((address_space(3))) bf16x8*)(kp+4096); kf[5]=*(const __attribute__((address_space(3))) bf16x8*)(kp+4608);
  kf[6]=*(const __attribute__((address_space(3))) bf16x8*)(kp+6144); kf[7]=*(const __attribute__((address_space(3))) bf16x8*)(kp+6656);
}
__device__ __forceinline__ void kload2(bf16x8*kf,lds_cptr kp,int j){ kf[2*j]=*(const __attribute__((address_space(3))) bf16x8*)(kp+j*2048); kf[2*j+1]=*(const __attribute__((address_space(3))) bf16x8*)(kp+j*2048+512); }
__device__ __forceinline__ s16x4 vtr(lds_cptr p){ return __builtin_bit_cast(s16x4,__builtin_amdgcn_ds_read_tr16_b64_v4i16((__attribute__((address_space(3))) v4i16_t*)p)); }
__device__ __forceinline__ float rowmax(const f32x16&p0,const f32x16&p1){
  float a=max3f(p0[0],p0[1],p1[0]),b=max3f(p0[2],p0[3],p1[1]);a=max3f(a,p1[2],p1[3]);
  #pragma unroll
  for(int r=4;r<16;r+=4){a=max3f(a,p0[r],p0[r+1]);b=max3f(b,p0[r+2],p0[r+3]);a=max3f(a,p1[r],p1[r+1]);b=max3f(b,p1[r+2],p1[r+3]);}
  const float m=max2f(a,b);
  auto rr=__builtin_amdgcn_permlane32_swap(__float_as_uint(m),__float_as_uint(m),false,false);
  return max2f(__uint_as_float(rr[0]),__uint_as_float(rr[1]));
}
__device__ __forceinline__ void pv(f32x16*o,int vb,bf16x8 pa0,bf16x8 pa1,bf16x8 pa2,bf16x8 pa3){
  #pragma unroll
  for(int d0=0;d0<2;++d0){s16x4 lo[4],hi[4];
    #pragma unroll
    for(int ks=0;ks<4;++ks){
      asm volatile("ds_read_b64_tr_b16 %0,%1 offset:%c2":"=&v"(lo[ks]):"v"(vb),"i"(d0*4096+ks*1024):"memory");
      asm volatile("ds_read_b64_tr_b16 %0,%1 offset:%c2":"=&v"(hi[ks]):"v"(vb),"i"(d0*4096+ks*1024+512):"memory");}
    asm volatile("s_waitcnt lgkmcnt(0)":::"memory");SBAR();
    #define PK(k) (bf16x8){lo[k][0],lo[k][1],lo[k][2],lo[k][3],hi[k][0],hi[k][1],hi[k][2],hi[k][3]}
    o[d0]=__builtin_amdgcn_mfma_f32_32x32x16_bf16(pa0,PK(0),o[d0],0,0,0);
    o[d0]=__builtin_amdgcn_mfma_f32_32x32x16_bf16(pa1,PK(1),o[d0],0,0,0);
    o[d0]=__builtin_amdgcn_mfma_f32_32x32x16_bf16(pa2,PK(2),o[d0],0,0,0);
    o[d0]=__builtin_amdgcn_mfma_f32_32x32x16_bf16(pa3,PK(3),o[d0],0,0,0);
    #undef PK
  }
}

#ifndef ATTN_STORE16
#define ATTN_STORE16(p,v) (*(u32x4*)(p)=(v))
#endif
template<int THRL> __device__ __forceinline__ void attn_unit(int b,int h,int qb,const bf16*Q,const bf16*__restrict__ K,const bf16*__restrict__ V,bf16*O,char*shm){
  const int tid=otid(),lane=tid&63,r32=lane&31,hi=lane>>5; const int wid=__builtin_amdgcn_readfirstlane(tid>>6);
  const long rowbase=(long)b*SEQ; const int q0=qb*QB;
  const bf16*Qw=Q+(rowbase+q0+wid*QBLK)*QP+h*D;
  const bf16*Kh=K+rowbase*KP+(h>>2)*D,*Vh=V+rowbase*KP+(h>>2)*D;
  const unsigned lds0=(unsigned)(uintptr_t)shm;
  float*wsf=(float*)(shm+LDS_WS)+wid*64;
  const bf16*ksrc=Kh+(long)lane*KP+wid*8;
  const bf16*vsrc=Vh+(long)(16*(wid&3)+(lane>>2))*KP+(wid>>2)*32+(lane&3)*8;
  const unsigned kdst=lds0+LDS_K+wid*1024, vdst=lds0+LDS_V+wid*1024;
  #define DMA_K(t,slot) glds16(ksrc+(long)(t)*KVBLK*KP,(unsigned)__builtin_amdgcn_readfirstlane(kdst+(slot)))
  #define DMA_V(t,slot) glds16(vsrc+(long)(t)*KVBLK*KP,(unsigned)__builtin_amdgcn_readfirstlane(vdst+(slot)))
  const int vb0=(int)(lds0+LDS_V)+((lane>>4)&1)*32+(lane&3)*8+(4*hi+((lane&15)>>2))*64;
  const char*Kbase=shm+LDS_K; bf16x8 kf[8];
  const lds_cptr shm3=(lds_cptr)shm; const lds_cptr kp0=shm3+LDS_K+hi*1024+r32*16; const lds_cptr vp0=shm3+LDS_V+((lane>>4)&1)*32+(lane&3)*8+(4*hi+((lane&15)>>2))*64;
  const int NT=SEQ/KVBLK;
  DMA_K(0,0);DMA_V(0,0);DMA_K(1,SLOTB);
  bf16x8 qr[4];
  #pragma unroll
  for(int d0=0;d0<4;++d0)qr[d0]=*reinterpret_cast<const bf16x8*>(&Qw[(long)r32*QP+d0*16+hi*8]);
  float mhat=0.f,l_reg=0.f;f32x16 o[2];o[0]=f32x16{};o[1]=f32x16{};f32x16 negm=f32x16{};asm volatile("":"+v"(negm));

  #define CMASK(P0,P1,t) do{}while(0)
  bool resc=false;
  #define START(P0,P1) do{ const float rm=rowmax(P0,P1); resc=false; \
    { const float dl=rm; mhat=fadd_s(mhat,dl); \
      _Pragma("unroll") for(int r=0;r<16;++r){P0[r]=fsub_s(P0[r],dl);P1[r]=fsub_s(P1[r],dl);} \
      _Pragma("unroll") for(int r=0;r<16;++r)negm[r]=-mhat; asm volatile("":"+v"(negm)); } \
    _Pragma("unroll") for(int r=0;r<16;++r)P0[r]=__builtin_amdgcn_exp2f(P0[r]); }while(0)
  #define RESC() do{ if(resc){ asm volatile("s_waitcnt lgkmcnt(0)":::"memory"); \
      _Pragma("unroll") for(int d_=0;d_<2;++d_) _Pragma("unroll") for(int r=0;r<16;++r)o[d_][r]*=wsf[crow(r,hi)]; } }while(0)
  f32x16 pA0,pA1,pB0,pB1;
  int sl_prev=0,sl_cur=0,sl_next=SLOTB;
  #define ROT() do{sl_prev=sl_cur;sl_cur=sl_next;sl_next=(sl_next==(NSLOT-1)*SLOTB)?0:sl_next+SLOTB;}while(0)
  DMA_K(2,2*SLOTB);
  WAIT_BAR(3);
  qkt(pA0,pA1,Kbase,qr,negm,r32,hi);asm volatile("s_nop 15\n\ts_nop 7":"+v"(pA0),"+v"(pA1));CMASK(pA0,pA1,0);
  START(pA0,pA1);
  _Pragma("unroll") for(int r=0;r<16;++r)pA1[r]=__builtin_amdgcn_exp2f(pA1[r]);
  WAIT_BAR(0);
  DMA_K(3,0);DMA_V(1,SLOTB);
  ROT();
  kload8(kf,kp0+sl_cur);
  WAIT_BAR(2);
  s16x4 vlo[8],vhi[8]; u32x4 pw0,pw1,pw2,pw3;
  #define PKW(P,B) cvtpk_s(P[B],P[B+1])
  #define PAF(k) __builtin_bit_cast(bf16x8,pw##k)
  #define VFR(i) (bf16x8){vlo[i][0],vlo[i][1],vlo[i][2],vlo[i][3],vhi[i][0],vhi[i][1],vhi[i][2],vhi[i][3]}
  #define PIN(x) asm volatile("":"+v"(x))
  #define MX3(a,b,c) __builtin_fmaxf(__builtin_fmaxf((a),(b)),(c))
  #define GAPA(MF,A0,A1,A2,A3,W0,W1,PW) do{ MF; sacc+=A0; sacc+=A1; sacc+=A2; sacc+=A3; PIN(sacc); W0; W1; PIN(PW); SBAR(); }while(0)
  #define EX(v) __builtin_amdgcn_exp2f(v)
  #define GAPB(MF,X,B) do{ MF; X[B]=EX(X[B]); X[B+1]=EX(X[B+1]); X[B+2]=EX(X[B+2]); X[B+3]=EX(X[B+3]); PIN(X); SBAR(); }while(0)
  #define VRD(i) do{ vlo[i]=vtr(vp_+(((i)>>2)*4096+((i)&3)*1024)); vhi[i]=vtr(vp_+(((i)>>2)*4096+((i)&3)*1024+512)); }while(0)
  #define KRD(G,j) do{ if(G){ kload2(kf,kp0+sl_next,j); SBAR(); } }while(0)
  #define STEP(C0,C1,P0,P1,t,GK,GV,GL) do{ SBAR(); \
    const lds_cptr vp_=vp0+sl_prev; \
    VRD(0); SBAR(); float sacc=(P0[0]+P0[1]); \
    GAPA(C0=__builtin_amdgcn_mfma_f32_32x32x16_bf16(kf[0],qr[0],negm,0,0,0), P0[2],P0[3],P0[4],P0[5],     pw0[0]=PKW(P0,0), pw0[1]=PKW(P0,2), pw0); \
    VRD(4); SBAR(); GAPA(C1=__builtin_amdgcn_mfma_f32_32x32x16_bf16(kf[1],qr[0],negm,0,0,0), P0[6],P0[7],P0[8],P0[9],     pw0[2]=PKW(P0,4), pw0[3]=PKW(P0,6), pw0); \
    VRD(1); SBAR(); GAPA(C0=__builtin_amdgcn_mfma_f32_32x32x16_bf16(kf[2],qr[1],C0,0,0,0),   P0[10],P0[11],P0[12],P0[13], pw1[0]=PKW(P0,8), pw1[1]=PKW(P0,10), pw1); \
    VRD(5); SBAR(); GAPA(C1=__builtin_amdgcn_mfma_f32_32x32x16_bf16(kf[3],qr[1],C1,0,0,0),   P0[14],P0[15],P1[0],P1[1],   pw1[2]=PKW(P0,12),pw1[3]=PKW(P0,14), pw1); \
    VRD(2); SBAR(); GAPA(C0=__builtin_amdgcn_mfma_f32_32x32x16_bf16(kf[4],qr[2],C0,0,0,0),   P1[2],P1[3],P1[4],P1[5],     pw2[0]=PKW(P1,0), pw2[1]=PKW(P1,2), pw2); \
    VRD(6); SBAR(); GAPA(C1=__builtin_amdgcn_mfma_f32_32x32x16_bf16(kf[5],qr[2],C1,0,0,0),   P1[6],P1[7],P1[8],P1[9],     pw2[2]=PKW(P1,4), pw2[3]=PKW(P1,6), pw2); \
    VRD(3); SBAR(); GAPA(C0=__builtin_amdgcn_mfma_f32_32x32x16_bf16(kf[6],qr[3],C0,0,0,0),   P1[10],P1[11],P1[12],P1[13], pw3[0]=PKW(P1,8), pw3[1]=PKW(P1,10), pw3); \
    VRD(7); SBAR(); GAPA(C1=__builtin_amdgcn_mfma_f32_32x32x16_bf16(kf[7],qr[3],C1,0,0,0),   P1[14],P1[15],0.f,0.f,       pw3[2]=PKW(P1,12),pw3[3]=PKW(P1,14), pw3); \
    l_reg+=sacc; \
    if(GK){DMA_K((t)+3,sl_cur);} if(GV){DMA_V((t)+1,sl_next);} \
    CMASK(C0,C1,t); \
    { float a=MX3(C0[0],C0[1],C1[0]),b=MX3(C0[2],C0[3],C1[1]); a=MX3(a,C1[2],C1[3]); \
      _Pragma("unroll") for(int r=4;r<16;r+=4){a=MX3(a,C0[r],C0[r+1]);b=MX3(b,C0[r+2],C0[r+3]);a=MX3(a,C1[r],C1[r+1]);b=MX3(b,C1[r+2],C1[r+3]);} \
      float rm=__builtin_fmaxf(a,b); { auto rr=__builtin_amdgcn_permlane32_swap(__float_as_uint(rm),__float_as_uint(rm),false,false); rm=__builtin_fmaxf(__uint_as_float(rr[0]),__uint_as_float(rr[1])); } \
      resc=false; \
      if(__builtin_expect(__any(rm>(float)THRL),0)){ const float dl=__builtin_fmaxf(rm,0.f); mhat+=dl; \
        _Pragma("unroll") for(int r=0;r<16;++r){C0[r]-=dl;C1[r]-=dl;} \
        _Pragma("unroll") for(int r=0;r<16;++r)negm[r]=-mhat; asm volatile("":"+v"(negm)); \
        const float f=__builtin_amdgcn_exp2f(-dl); l_reg*=f; if(hi==0)wsf[r32]=f; resc=true; } } \
    SBAR(); \
    GAPB(o[0]=__builtin_amdgcn_mfma_f32_32x32x16_bf16(PAF(0),VFR(0),o[0],0,0,0), C0,0); \
    GAPB(o[1]=__builtin_amdgcn_mfma_f32_32x32x16_bf16(PAF(0),VFR(4),o[1],0,0,0), C0,4); \
    KRD(GL,0); GAPB(o[0]=__builtin_amdgcn_mfma_f32_32x32x16_bf16(PAF(1),VFR(1),o[0],0,0,0), C0,8); \
    KRD(GL,1); GAPB(o[1]=__builtin_amdgcn_mfma_f32_32x32x16_bf16(PAF(1),VFR(5),o[1],0,0,0), C0,12); \
    KRD(GL,2); GAPB(o[0]=__builtin_amdgcn_mfma_f32_32x32x16_bf16(PAF(2),VFR(2),o[0],0,0,0), C1,0); \
    KRD(GL,3); GAPB(o[1]=__builtin_amdgcn_mfma_f32_32x32x16_bf16(PAF(2),VFR(6),o[1],0,0,0), C1,4); \
    GAPB(o[0]=__builtin_amdgcn_mfma_f32_32x32x16_bf16(PAF(3),VFR(3),o[0],0,0,0), C1,8); \
    GAPB(o[1]=__builtin_amdgcn_mfma_f32_32x32x16_bf16(PAF(3),VFR(7),o[1],0,0,0), C1,12); \
    }while(0)
  int t=1;
  #undef CMASK
  #define CMASK(P0,P1,t) do{}while(0)
  for(;t+5<NT;t+=2){
    STEP(pB0,pB1,pA0,pA1,t,true,true,true);     WAIT_BAR(2); RESC(); ROT();
    STEP(pA0,pA1,pB0,pB1,t+1,true,true,true);   WAIT_BAR(2); RESC(); ROT();
  }
  #undef CMASK
  #define CMASK(P0,P1,t) do{}while(0)
  #define ENDW(tt) do{ if((tt)+3<NT){WAIT_BAR(2);} else if((tt)+2<NT){WAIT_BAR(1);} else {WAIT_BAR(0);} }while(0)
  for(;t+1<NT;t+=2){
    STEP(pB0,pB1,pA0,pA1,t,(t+3<NT),(t+1<NT),(t+1<NT));       ENDW(t);   RESC(); ROT();
    STEP(pA0,pA1,pB0,pB1,t+1,(t+4<NT),(t+2<NT),(t+2<NT));     ENDW(t+1); RESC(); ROT();
  }
  STEP(pB0,pB1,pA0,pA1,NT-1,false,false,false); RESC();
  { float sacc=pB0[0]+pB0[1]; _Pragma("unroll") for(int r=2;r<16;++r)sacc+=pB0[r]; _Pragma("unroll") for(int r=0;r<16;++r)sacc+=pB1[r]; l_reg+=sacc;
    pw0=(u32x4){PKW(pB0,0),PKW(pB0,2),PKW(pB0,4),PKW(pB0,6)};pw1=(u32x4){PKW(pB0,8),PKW(pB0,10),PKW(pB0,12),PKW(pB0,14)};pw2=(u32x4){PKW(pB1,0),PKW(pB1,2),PKW(pB1,4),PKW(pB1,6)};pw3=(u32x4){PKW(pB1,8),PKW(pB1,10),PKW(pB1,12),PKW(pB1,14)};
    SBAR(); pv(o,vb0+sl_cur,PAF(0),PAF(1),PAF(2),PAF(3)); }
  #undef PKW
  #undef PAF
  #undef VFR
  #undef PIN
  #undef MX3
  #undef GAPA
  #undef GAPB
  #undef EX
  #undef VRD
  #undef KRD
  #undef STEP
  #undef ENDW
  {auto rr=__builtin_amdgcn_permlane32_swap(__float_as_uint(l_reg),__float_as_uint(l_reg),false,false);l_reg=__uint_as_float(rr[0])+__uint_as_float(rr[1]);}
  if(hi==0)wsf[32+r32]=l_reg;asm volatile("s_waitcnt lgkmcnt(0)":::"memory");
  float rli[16];
  #pragma unroll
  for(int r=0;r<16;++r)rli[r]=__builtin_amdgcn_rcpf(wsf[32+crow(r,hi)]);
  bf16*Ow=O+(rowbase+q0+wid*QBLK)*OP+h*D;
  { bf16*stg=(bf16*)(shm+LDS_OST)+wid*2048;
    #pragma unroll
    for(int r=0;r<16;++r){const int orow=crow(r,hi);
      #pragma unroll
      for(int d0=0;d0<2;++d0)stg[orow*64+d0*32+r32]=__float2bfloat16(o[d0][r]*rli[r]);}
    asm volatile("s_waitcnt lgkmcnt(0)":::"memory");
    #pragma unroll
    for(int i=0;i<4;++i){const int row=i*8+(lane>>3),ch=lane&7; const u32x4 v=*(const u32x4*)(stg+row*64+ch*8); ATTN_STORE16(Ow+(long)row*OP+ch*8,v);} }
  asm volatile("s_waitcnt lgkmcnt(0)\n\ts_barrier":::"memory");
  #undef DMA_K
  #undef DMA_V
  #undef CMASK
  #undef START
  #undef RESC
  #undef ROT
}
constexpr int ATTN_LDS_BYTES=LDS_BYTES;
struct AttnTensors { const bf16* Q; const bf16* K; const bf16* V; bf16* O; };
struct AttnUnit { int bh; int qb; };
struct StaticOrder {
  int vcu, per;
  __device__ __forceinline__ explicit StaticOrder(int grid,int block){ vcu=(grid%8==0)?(block%8)*(grid/8)+block/8:block; per=(1024+grid-1)/grid; }
  __device__ __forceinline__ bool next(int i,AttnUnit&u)const{ if(i>=per)return false; const int idx=vcu*per+i; if(idx>=1024)return false;
    const int bkv=idx>>6, hl=(idx&63)>>4; u.bh=(bkv>>1)*NHEAD+(bkv&1)*4+hl; u.qb=idx&15; return true; }
  __device__ __forceinline__ void a_ready(const AttnUnit&)const{}
  __device__ __forceinline__ void done(const AttnUnit&)const{}
};
template<class Sched,int THRL=8> __device__ __forceinline__ void attn_phase(char*lds,const AttnTensors&T,const Sched&S){
  AttnUnit u;
  for(int i=0;S.next(i,u);++i){ S.a_ready(u); attn_unit<THRL>(u.bh/NHEAD,u.bh%NHEAD,u.qb,T.Q,T.K,T.V,T.O,lds); S.done(u); }
}
#undef SBAR
#undef WAIT_BAR
}
#define GAS __attribute__((address_space(1)))
#define LAS __attribute__((address_space(3)))
typedef unsigned short bf16_t;
typedef unsigned v4u __attribute__((ext_vector_type(4)));
typedef unsigned v2u __attribute__((ext_vector_type(2)));
typedef float f32x4 __attribute__((ext_vector_type(4)));
typedef float f32x16 __attribute__((ext_vector_type(16)));
typedef float f32x2 __attribute__((ext_vector_type(2)));
typedef short bf16x8 __attribute__((ext_vector_type(8)));
using pg8::cvt_pk_bf16; using pg8::bflo; using pg8::bfhi; using pg8::gelu_tanh; using pg8::sigmoidf_;

constexpr int NWAVES = 8, NTHR = 512;
constexpr int BATCH = 8, SEQ = 4096, DM = 1024, MTOK = BATCH * SEQ, DFF = 4096, DEPTH = 4;
constexpr int LDS_BYTES = 147456;
constexpr size_t MiB = 1u << 20;
constexpr size_t WS_ROPE = 512 * 1024, WS_MOD = 1 * MiB, WS_SHW1 = 2 * MiB, WS_SHW2 = WS_SHW1 + 256 * 1024, WS_ROWSS = 3 * MiB, WS_A32 = 5 * MiB;
constexpr size_t WS_WHIN = 6 * MiB, WS_WHOUT = 11 * MiB, WS_WGLU = 15 * MiB, WS_WRIN = 16 * MiB, WS_WROUT = 24 * MiB, WS_W1 = 28 * MiB, WS_W2 = 60 * MiB;
constexpr size_t WS_TT = 92 * MiB, WS_PT = 140 * MiB, WS_HW = 156 * MiB, WS_R = 220 * MiB, WS_END = 476 * MiB;
constexpr size_t R_AP = WS_R, R_Q = WS_R + 48 * MiB, R_K = WS_R + 80 * MiB, R_V = WS_R + 88 * MiB, R_E = WS_R + 96 * MiB, R_G = WS_R + 128 * MiB, R_MIX = WS_R + 192 * MiB;
constexpr size_t R_QP = WS_R + 160 * MiB, R_KP = R_K;
constexpr size_t R_Z = WS_R, R_HF = WS_R + 128 * MiB, R_HID = WS_R;
constexpr size_t TT_LAYER = (size_t)32 * 512 * 768, PT_LAYER = (size_t)32 * 256 * 512;

__device__ __forceinline__ f32x2 mk2(float a, float b) { f32x2 r; r.x = a; r.y = b; return r; }
__device__ __forceinline__ float wave_sum(float v, int lane) {
#pragma unroll
    for (int o = 1; o < 64; o <<= 1) v += shx(v, o, lane);
    return v;
}
__device__ __forceinline__ unsigned f2bf(float f) { unsigned u = __builtin_bit_cast(unsigned, f); return (u + 0x7fffu + ((u >> 16) & 1u)) >> 16; }
__device__ __forceinline__ unsigned pk2(float lo, float hi) { return cvt_pk_bf16(lo, hi); }
__device__ __forceinline__ void dcis(double ang, double& c, double& s) {
    const double n = __builtin_rint(ang * 0.15915494309189535);
    const double r = __builtin_fma(-n, 6.283185307179586, ang);
    const double x = r * 0.0625, x2 = x * x;
    double sn = x * (1.0 + x2 * (-1.0 / 6.0 + x2 * (1.0 / 120.0 + x2 * (-1.0 / 5040.0 + x2 * (1.0 / 362880.0 + x2 * (-1.0 / 39916800.0 + x2 * (1.0 / 6227020800.0)))))));
    double cs = 1.0 + x2 * (-0.5 + x2 * (1.0 / 24.0 + x2 * (-1.0 / 720.0 + x2 * (1.0 / 40320.0 + x2 * (-1.0 / 3628800.0 + x2 * (1.0 / 479001600.0))))));
#pragma unroll
    for (int i = 0; i < 4; ++i) { const double c2 = cs * cs - sn * sn, s2 = 2.0 * cs * sn; cs = c2; sn = s2; }
    c = cs; s = sn;
}
__device__ __forceinline__ double dexp_small(double x) {
    const double y = x * (1.0 / 64.0);
    double e = 1.0 + y * (1.0 + y * (0.5 + y * (1.0 / 6.0 + y * (1.0 / 24.0 + y * (1.0 / 120.0 + y * (1.0 / 720.0 + y * (1.0 / 5040.0 + y * (1.0 / 40320.0))))))));
#pragma unroll
    for (int i = 0; i < 6; ++i) e = e * e;
    return e;
}

__device__ __forceinline__ void p0_transpose_load(f32x4 (&v)[16], const float* W, int N, int item, int lane, bool nt) {
    const int nblk = N / 64, kb = item / nblk, nb = item % nblk, k0 = 64 * kb, n0 = 64 * nb;
#pragma unroll
    for (int i = 0; i < 16; ++i) { const f32x4* p = (const f32x4*)(W + (size_t)(k0 + (lane >> 4) + 4 * i) * N + n0 + 4 * (lane & 15)); v[i] = nt ? __builtin_nontemporal_load(p) : *p; }
}
__device__ __forceinline__ void p0_transpose_store(const f32x4 (&v)[16], int K, int N, bf16_t* WT, LAS float* scr, int item, int lane) {
    const int nblk = N / 64, kb = item / nblk, nb = item % nblk, k0 = 64 * kb, n0 = 64 * nb;
#pragma unroll
    for (int i = 0; i < 16; ++i) { LAS float* d = scr + ((lane >> 4) + 4 * i) * 65 + 4 * (lane & 15); d[0] = v[i][0]; d[1] = v[i][1]; d[2] = v[i][2]; d[3] = v[i][3]; }
    asm volatile("s_waitcnt lgkmcnt(0)" ::: "memory");
    const int c = lane & 7;
#pragma unroll
    for (int j = 0; j < 8; ++j) { const int n = (lane >> 3) + 8 * j; const LAS float* s = scr + (8 * c) * 65 + n;
        v4u o; o.x = pk2(s[0 * 65], s[1 * 65]); o.y = pk2(s[2 * 65], s[3 * 65]); o.z = pk2(s[4 * 65], s[5 * 65]); o.w = pk2(s[6 * 65], s[7 * 65]);
        *(v4u*)(WT + (size_t)(n0 + n) * K + k0 + 8 * c) = o; }
    asm volatile("s_waitcnt lgkmcnt(0)" ::: "memory");
}
__device__ __forceinline__ void skinny_gemm(const LAS float* Al, LAS float* red, const float* W, int ldw, int col0, float* out, int ldo, const float* bias, int tid, bool nt = false) {
    const int wave = tid >> 6, lane = tid & 63;
    float acc[8];
#pragma unroll
    for (int b = 0; b < 8; ++b) acc[b] = 0.f;
    const float* wp = W + (size_t)(128 * wave) * ldw + col0 + lane;
#pragma unroll 4
    for (int k4 = 0; k4 < 32; ++k4) {
        float w0, w1, w2, w3;
        if (nt) { w0 = __builtin_nontemporal_load(wp + (size_t)(4 * k4) * ldw); w1 = __builtin_nontemporal_load(wp + (size_t)(4 * k4 + 1) * ldw); w2 = __builtin_nontemporal_load(wp + (size_t)(4 * k4 + 2) * ldw); w3 = __builtin_nontemporal_load(wp + (size_t)(4 * k4 + 3) * ldw); }
        else { w0 = wp[(size_t)(4 * k4) * ldw]; w1 = wp[(size_t)(4 * k4 + 1) * ldw]; w2 = wp[(size_t)(4 * k4 + 2) * ldw]; w3 = wp[(size_t)(4 * k4 + 3) * ldw]; }
#pragma unroll
        for (int b = 0; b < 8; ++b) { const f32x4 a4 = *(const LAS f32x4*)(Al + b * 1024 + 128 * wave + 4 * k4); acc[b] += (a4[0] * w0 + a4[1] * w1) + (a4[2] * w2 + a4[3] * w3); }
    }
#pragma unroll
    for (int b = 0; b < 8; ++b) red[(wave * 8 + b) * 64 + lane] = acc[b];
    __syncthreads();
    { const int b = tid >> 6; float s = 0.f;
#pragma unroll
      for (int w = 0; w < 8; ++w) s += red[(w * 8 + b) * 64 + lane];
      out[(size_t)b * ldo + col0 + lane] = s + (bias ? bias[col0 + lane] : 0.f); }
    __syncthreads();
}

__device__ __forceinline__ void s5_tables(int e, int g, const float* lam_re, const float* lam_im, const float* log_dt, const float* b_re, const float* b_im, const float* c_re, const float* c_im,
                                          bf16_t* TT, bf16_t* PT, f32x2* A32, LAS unsigned char* lds, int tid) {
    LAS f32x2* PW = (LAS f32x2*)lds;
    LAS f32x2* BB = PW + 2 * 64 * 33;
    LAS f32x2* CC = BB + 2 * 64 * 16;
    LAS float* KF = (LAS float*)(CC + 2 * 16 * 65);
    if (tid < 128) {
        const int d = tid >> 6, p = tid & 63;
        const int li_ = ((e * 2 + d) * 32 + g) * 64 + p;
        const double lr = (double)fminf(lam_re[li_], -1e-4f), li = (double)lam_im[li_];
        const double dt = dexp_small((double)log_dt[(e * 2 + d) * 32 + g] * 0.25); const double dt4 = (dt * dt) * (dt * dt);
        double ar1 = 1.0, ai1 = 0.0;
        for (int tau = 0; tau <= 32; ++tau) {
            const double mag = dexp_small((double)tau * lr * dt4);
            double c, s; dcis((double)tau * li * dt4, c, s);
            PW[(d * 64 + p) * 33 + tau] = mk2((float)(mag * c), (float)(mag * s));
            if (tau == 1) { ar1 = mag * c; ai1 = mag * s; }
            if (tau == 32) A32[(g * 2 + d) * 64 + p] = mk2((float)(mag * c), (float)(mag * s));
        }
        const double den = lr * lr + li * li, nr = ar1 - 1.0;
        const double fre = (nr * lr + ai1 * li) / den, fim = (ai1 * lr - nr * li) / den;
        for (int c = 0; c < 16; ++c) { const double br = (double)b_re[(size_t)li_ * 16 + c], bi = (double)b_im[(size_t)li_ * 16 + c];
            BB[(d * 64 + p) * 16 + c] = mk2((float)(fre * br - fim * bi), (float)(fre * bi + fim * br)); }
    }
#pragma unroll
    for (int i = 0; i < 4; ++i) { const int idx = tid + 512 * i; const int d = idx >> 10, r = idx & 1023;
        const size_t src = (size_t)((e * 2 + d) * 32 + g) * 1024 + r; CC[(idx >> 6) * 65 + (idx & 63)] = mk2(c_re[src], c_im[src]); }
    __syncthreads();
    {   const int d = tid >> 8, c = (tid >> 4) & 15, cp = tid & 15;
        float kacc[32];
#pragma unroll
        for (int t = 0; t < 32; ++t) kacc[t] = 0.f;
        for (int p = 0; p < 64; ++p) {
            const f32x2 cc = CC[(d * 16 + c) * 65 + p], bb = BB[(d * 64 + p) * 16 + cp];
            const float cbr = cc.x * bb.x - cc.y * bb.y, cbi = cc.x * bb.y + cc.y * bb.x;
#pragma unroll
            for (int t = 0; t < 32; ++t) { const f32x2 pw = PW[(d * 64 + p) * 33 + t]; kacc[t] += cbr * pw.x - cbi * pw.y; }
        }
#pragma unroll
        for (int t = 0; t < 32; ++t) KF[(d * 32 + t) * 260 + c * 16 + cp] = kacc[t];
    }
    __syncthreads();
    for (int i = 0; i < 64; ++i) {
        const int idx = tid + 512 * i, n = idx >> 6, ch = idx & 63, sl = ch >> 1, cp0 = (ch & 1) * 8, tl = n >> 4, c = n & 15;
        f32x4 va = (f32x4){0.f, 0.f, 0.f, 0.f}, vb = va;
        if (tl >= sl) { const LAS f32x4* s = (const LAS f32x4*)(KF + (tl - sl) * 260 + c * 16 + cp0); va += s[0]; vb += s[1]; }
        if (sl >= tl) { const LAS f32x4* s = (const LAS f32x4*)(KF + (32 + sl - tl) * 260 + c * 16 + cp0); va += s[0]; vb += s[1]; }
        v4u o; o.x = pk2(va[0], va[1]); o.y = pk2(va[2], va[3]); o.z = pk2(vb[0], vb[1]); o.w = pk2(vb[2], vb[3]);
        *(v4u*)(TT + ((size_t)(g * 512 + n) * 768 + sl * 16 + cp0)) = o;
    }
    for (int i = 0; i < 32; ++i) {
        const int n = tid, ch = i, col0 = ch * 8, q = col0 >> 6, p0 = col0 & 63, d = q >> 1, tl = n >> 4, c = n & 15;
        const int tau = d == 0 ? tl + 1 : 32 - tl;
        float v[8];
#pragma unroll
        for (int j = 0; j < 8; ++j) { const f32x2 cc = CC[(d * 16 + c) * 65 + p0 + j], pw = PW[(d * 64 + p0 + j) * 33 + tau];
            const float wr_ = cc.x * pw.x - cc.y * pw.y, wi_ = cc.x * pw.y + cc.y * pw.x; v[j] = (q & 1) ? -wi_ : wr_; }
        v4u o; o.x = pk2(v[0], v[1]); o.y = pk2(v[2], v[3]); o.z = pk2(v[4], v[5]); o.w = pk2(v[6], v[7]);
        *(v4u*)(TT + ((size_t)(g * 512 + n) * 768 + 512 + col0)) = o;
    }
    for (int i = 0; i < 32; ++i) {
        const int idx = tid + 512 * i, n = idx >> 6, ch = idx & 63, sl = ch >> 1, cp0 = (ch & 1) * 8, d = n >> 7, ri = (n >> 6) & 1, p = n & 63;
        const int tau = d == 0 ? 31 - sl : sl;
        const f32x2 pw = PW[(d * 64 + p) * 33 + tau];
        float v[8];
#pragma unroll
        for (int j = 0; j < 8; ++j) { const f32x2 bb = BB[(d * 64 + p) * 16 + cp0 + j]; v[j] = ri ? (pw.x * bb.y + pw.y * bb.x) : (pw.x * bb.x - pw.y * bb.y); }
        v4u o; o.x = pk2(v[0], v[1]); o.y = pk2(v[2], v[3]); o.z = pk2(v[4], v[5]); o.w = pk2(v[6], v[7]);
        *(v4u*)(PT + ((size_t)(g * 256 + n) * 512 + sl * 16 + cp0)) = o;
    }
    __syncthreads();
}

__device__ __forceinline__ void rope_table(f32x2* gtab, int tid) {
    for (int idx = tid; idx < 1024; idx += NTHR) { const int pos = idx >> 4, f = idx & 15;
        const float invf = __builtin_amdgcn_exp2f(-(float)f * (13.287712379549449f / 16.0f));
        double c, s; dcis((double)((float)pos * invf), c, s); gtab[idx] = mk2((float)c, (float)s); }
}
__device__ __forceinline__ void qkprep_phase(const bf16_t* Q, const bf16_t* Kb, bf16_t* Qo, bf16_t* Ko, const float* qn, const float* kn, const f32x2* gtab, LAS unsigned char* lds, int tid, int gw, int ngw, int it_end, int k_lo, int k_hi) {
    LAS f32x2* tab = (LAS f32x2*)lds;
    for (int idx = tid; idx < 1024; idx += NTHR) tab[idx] = gtab[idx];
    __syncthreads();
    const int lane = tid & 63, j = lane & 7;
    const int axis = j >> 2, fb = (j & 1) * 8; const bool second = (j & 2) != 0;
    const float C2 = 0.125f * 1.4426950408889634f;
    const int wv_ = tid >> 6;
    const f32x4 qw0 = *(const f32x4*)(qn + j * 8), qw1 = *(const f32x4*)(qn + j * 8 + 4), kw0 = *(const f32x4*)(kn + j * 8), kw1 = *(const f32x4*)(kn + j * 8 + 4);
    for (int it0 = gw; ; it0 += 4 * ngw) {
        int itv[4]; bool any = false;
#pragma unroll
        for (int u = 0; u < 4; ++u) { const int i0_ = it0 + u * ngw; int it = i0_;
            if (i0_ >= it_end) { it = MTOK + k_lo + wv_ + ((i0_ - it_end) / ngw) * NWAVES; if (it >= MTOK + k_hi) it = -1; }
            itv[u] = it; any = any || it >= 0; }
        if (!any) break;
        v4u raw[4];
#pragma unroll
        for (int u = 0; u < 4; ++u) { const int it = itv[u]; raw[u] = (v4u){0u, 0u, 0u, 0u};
            if (it >= 0) raw[u] = (it < MTOK) ? *(const v4u*)(Q + (size_t)it * 512 + lane * 8) : *(const v4u*)(Kb + (size_t)((it - MTOK) * 4 + (lane >> 4)) * 128 + (lane & 15) * 8); }
#pragma unroll
        for (int u = 0; u < 4; ++u) { const int it = itv[u]; if (it < 0) continue;
            const bool isq = it < MTOK;
            const int tok = isq ? it : (it - MTOK) * 4 + (lane >> 4);
            bf16_t* optr = isq ? Qo + (size_t)tok * 512 + lane * 8 : Ko + (size_t)tok * 128 + (lane & 15) * 8;
            const float scale = isq ? C2 : 1.0f;
            const f32x4 w0 = isq ? qw0 : kw0, w1 = isq ? qw1 : kw1;
            const int s = tok & 4095, pos = axis == 0 ? (s >> 6) : (s & 63);
            const v4u rw = raw[u];
            float x[8] = {bflo(rw.x), bfhi(rw.x), bflo(rw.y), bfhi(rw.y), bflo(rw.z), bfhi(rw.z), bflo(rw.w), bfhi(rw.w)};
            float ss = 0.f;
#pragma unroll
            for (int i = 0; i < 8; ++i) ss += x[i] * x[i];
            ss += shx(ss, 1, lane); ss += shx(ss, 2, lane); ss += shx(ss, 4, lane);
            const float rs = __builtin_amdgcn_rsqf(ss * (1.0f / 64.0f) + 1e-6f);
            float y[8], o[8];
#pragma unroll
            for (int i = 0; i < 8; ++i) y[i] = x[i] * rs * (i < 4 ? w0[i] : w1[i - 4]);
#pragma unroll
            for (int i = 0; i < 8; ++i) { const float pr = shx(y[i], 2, lane); const f32x2 cs = tab[pos * 16 + fb + i];
                o[i] = (second ? (y[i] * cs.x + pr * cs.y) : (y[i] * cs.x - pr * cs.y)) * scale; }
            v4u w; w.x = cvt_pk_bf16(o[0], o[1]); w.y = cvt_pk_bf16(o[2], o[3]); w.z = cvt_pk_bf16(o[4], o[5]); w.w = cvt_pk_bf16(o[6], o[7]);
            *(v4u*)optr = w; }
    }
}

__device__ __forceinline__ void s5_scan_phase(const float* E, bf16_t* AP, const f32x2* A32, LAS unsigned char* lds, int tid, int it_begin, int it_end, int it_step) {
    LAS f32x2* XC = (LAS f32x2*)lds;
    for (int it = it_begin; it < it_end; it += it_step) {
        const int g = it & 31, b = it >> 5;
        const int st = tid & 127, seg = tid >> 7, d = st >> 6, p = st & 63;
        const f32x2 a = A32[(g * 2 + d) * 64 + p];
        const float* Eb = E + (size_t)(g * 1024 + b * 128) * 256 + d * 128 + p;
        bf16_t* Hb = AP + (size_t)(g * 1024 + b * 128) * 768 + 512 + d * 128 + p;
        float er[32], ei[32];
#pragma unroll
        for (int j = 0; j < 32; ++j) { const int q = 32 * seg + j, k = d ? 127 - q : q; er[j] = Eb[(size_t)k * 256]; ei[j] = Eb[(size_t)k * 256 + 64]; }
        float hr = 0.f, hi = 0.f;
#pragma unroll
        for (int j = 0; j < 32; ++j) { const float xr = er[j], xi = ei[j]; er[j] = hr; ei[j] = hi; const float nr = a.x * hr - a.y * hi + xr, ni = a.x * hi + a.y * hr + xi; hr = nr; hi = ni; }
        XC[seg * 128 + st] = mk2(hr, hi);
        float pr = a.x, pi = a.y;
#pragma unroll
        for (int i = 0; i < 5; ++i) { const float nr = pr * pr - pi * pi, ni = 2.f * pr * pi; pr = nr; pi = ni; }
        __syncthreads();
        float cr = 0.f, ci = 0.f;
        for (int s = 0; s < seg; ++s) { const f32x2 x = XC[s * 128 + st]; const float nr = pr * cr - pi * ci + x.x, ni = pr * ci + pi * cr + x.y; cr = nr; ci = ni; }
#pragma unroll
        for (int j = 0; j < 32; ++j) { const int q = 32 * seg + j, k = d ? 127 - q : q;
            Hb[(size_t)k * 768] = (bf16_t)f2bf(er[j] + cr); Hb[(size_t)k * 768 + 64] = (bf16_t)f2bf(ei[j] + ci);
            const float nr = a.x * cr - a.y * ci, ni = a.x * ci + a.y * cr; cr = nr; ci = ni; }
        __syncthreads();
    }
}

__device__ __forceinline__ float frcp(float x) { return __builtin_amdgcn_rcpf(x); }
__device__ __forceinline__ float fsig(float x) { return frcp(1.0f + __builtin_amdgcn_exp2f(-1.4426950408889634f * x)); }
__device__ __forceinline__ float fgelu(float x) { return x * frcp(1.0f + __builtin_amdgcn_exp2f(x * (-2.3022082f + -0.10294324f * x * x))); }
__device__ __forceinline__ f32x2 fgelu2(f32x2 x) { const f32x2 a = x * (x * x * (-0.10294324f) + (-2.3022082f)); f32x2 e; e.x = __builtin_amdgcn_exp2f(a.x); e.y = __builtin_amdgcn_exp2f(a.y); e = e + 1.0f; f32x2 r; r.x = frcp(e.x); r.y = frcp(e.y); return x * r; }
__device__ __forceinline__ void rglru_phase(int o, const bf16_t* Z, bf16_t* HF, bf16_t* MIX, const float* conv_w, const float* conv_b, const float* ra_w, const float* ra_b,
                                            const float* ix_w, const float* ix_b, const float* lam, LAS unsigned char* lds, int tid, int bid, int G) {
    LAS bf16_t* XA = (LAS bf16_t*)lds;
    LAS float* SA = (LAS float*)(lds + 36864);
    LAS float* SB = SA + 256 * 33;
    LAS float* SEGA = SB + 256 * 33;
    LAS float* SEGB = SEGA + 512;
    LAS float* CAR = SEGB + 512;
    LAS bf16_t* RAW = (LAS bf16_t*)(lds + 36864 + 67584 + 4096 + 256);
    const int wave = tid >> 6, lane = tid & 63, n32 = lane & 31, hi = lane >> 5;
    for (int unit = bid; unit < 256; unit += G) {
        const int b = unit >> 5, hd = (unit & 31) >> 1, hf = unit & 1;
        const int ic0 = 64 * hd, oc0 = ic0 + 32 * hf, cg = tid & 7;
        float cw[4][8], cb[8];
#pragma unroll
        for (int i = 0; i < 8; ++i) { cb[i] = conv_b[o * 1024 + ic0 + 8 * cg + i];
#pragma unroll
            for (int j = 0; j < 4; ++j) cw[j][i] = conv_w[(o * 4 + j) * 1024 + ic0 + 8 * cg + i]; }
        const bf16_t* Zx = Z + (size_t)b * SEQ * 2048 + 1024 + ic0;
#pragma unroll 1
        for (int dir = 0; dir < 2; ++dir) {
            bf16x8 BR[4], BI[4];
#pragma unroll
            for (int ks = 0; ks < 4; ++ks)
#pragma unroll
                for (int i = 0; i < 8; ++i) { const int k = 16 * ks + 8 * hi + i; const size_t off = ((size_t)((o * 2 + dir) * 16 + hd) * 64 + k) * 64 + 32 * hf + n32;
                    BR[ks][i] = (short)f2bf(-1.4426950408889634f * ra_w[off]); BI[ks][i] = (short)f2bf(-1.4426950408889634f * ix_w[off]); }
            const int och = oc0 + n32;
            const float rab = -1.4426950408889634f * ra_b[(o * 2 + dir) * 1024 + och], ixb = -1.4426950408889634f * ix_b[(o * 2 + dir) * 1024 + och];
            const float lm = lam[(o * 2 + dir) * 1024 + och];
            const float sp8 = 8.0f * 1.4426950408889634f * (fmaxf(-lm, 0.f) + log1pf(__expf(-fabsf(lm))));
            if (tid < 32) CAR[tid] = 0.f;
            v4u pre[5];
            {   const int t0 = dir ? 256 * 15 : 0;
#pragma unroll
                for (int k = 0; k < 5; ++k) { const int idx = tid + 512 * k, r = idx >> 3, p8 = idx & 7, ts = t0 - 2 + r;
                    pre[k] = (v4u){0u, 0u, 0u, 0u};
                    if (idx < 2072 && ts >= 0 && ts < SEQ) pre[k] = *(const v4u*)(Zx + (size_t)ts * 2048 + 8 * p8); }
            }
#pragma unroll 1
            for (int ci = 0; ci < 16; ++ci) {
                const int c = dir ? 15 - ci : ci, t0 = 256 * c;
                const int tid = otid(), wave = tid >> 6, lane = tid & 63, n32 = lane & 31, hi = lane >> 5, cg = tid & 7;
#pragma unroll
                for (int k = 0; k < 5; ++k) { const int idx = tid + 512 * k, r = idx >> 3, p8 = idx & 7; if (idx < 2072) *(LAS v4u*)(RAW + r * 72 + 8 * p8) = pre[k]; }
                __syncthreads();
                if (ci < 15) { const int tn = dir ? t0 - 256 : t0 + 256;
#pragma unroll
                    for (int k = 0; k < 5; ++k) { const int idx = tid + 512 * k, r = idx >> 3, p8 = idx & 7, ts = tn - 2 + r;
                        pre[k] = (v4u){0u, 0u, 0u, 0u};
                        if (idx < 2072 && ts >= 0 && ts < SEQ) pre[k] = *(const v4u*)(Zx + (size_t)ts * 2048 + 8 * p8); } }
                v4u gtv[2], hfv[2];
                if (dir) {
#pragma unroll
                    for (int i2 = 0; i2 < 2; ++i2) { const int idx = tid + 512 * i2, tt = idx >> 2, c8 = (idx & 3) * 8; const size_t m = (size_t)b * SEQ + t0 + tt;
                        gtv[i2] = *(const v4u*)(Z + m * 2048 + oc0 + c8); hfv[i2] = *(const v4u*)(HF + m * 1024 + oc0 + c8); } }
#pragma unroll 2
                for (int i4 = 0; i4 < 4; ++i4) {
                    const int tt = (tid >> 3) + 64 * i4;
                    float xc[8];
#pragma unroll
                    for (int i = 0; i < 8; ++i) xc[i] = cb[i];
#pragma unroll
                    for (int j = 0; j < 4; ++j) { const v4u raw = *(const LAS v4u*)(RAW + (tt + j) * 72 + 8 * cg);
                        xc[0] += cw[j][0] * bflo(raw.x); xc[1] += cw[j][1] * bfhi(raw.x); xc[2] += cw[j][2] * bflo(raw.y); xc[3] += cw[j][3] * bfhi(raw.y);
                        xc[4] += cw[j][4] * bflo(raw.z); xc[5] += cw[j][5] * bfhi(raw.z); xc[6] += cw[j][6] * bflo(raw.w); xc[7] += cw[j][7] * bfhi(raw.w); }
                    v4u w; w.x = cvt_pk_bf16(xc[0], xc[1]); w.y = cvt_pk_bf16(xc[2], xc[3]); w.z = cvt_pk_bf16(xc[4], xc[5]); w.w = cvt_pk_bf16(xc[6], xc[7]);
                    *(LAS v4u*)(XA + tt * 72 + 8 * cg) = w;
                    if ((cg >> 2) == hf) {
#pragma unroll
                        for (int i = 0; i < 8; ++i) SB[tt * 33 + (8 * cg - 32 * hf) + i] = xc[i]; }
                }
                __syncthreads();
                f32x16 accR, accI;
#pragma unroll
                for (int r = 0; r < 16; ++r) { accR[r] = rab; accI[r] = ixb; }
#pragma unroll
                for (int ks = 0; ks < 4; ++ks) { const bf16x8 a = *(const LAS bf16x8*)(XA + (32 * wave + n32) * 72 + 16 * ks + 8 * hi);
                    accR = __builtin_amdgcn_mfma_f32_32x32x16_bf16(a, BR[ks], accR, 0, 0, 0); accI = __builtin_amdgcn_mfma_f32_32x32x16_bf16(a, BI[ks], accI, 0, 0, 0); }
#pragma unroll
                for (int r = 0; r < 16; r += 2) { const int t0_ = (32 * wave + (r & 3) + 8 * (r >> 2) + 4 * hi) * 33 + n32, t1_ = t0_ + 33;
                    f32x2 dR, dI; dR.x = __builtin_amdgcn_exp2f(accR[r]); dR.y = __builtin_amdgcn_exp2f(accR[r + 1]); dI.x = __builtin_amdgcn_exp2f(accI[r]); dI.y = __builtin_amdgcn_exp2f(accI[r + 1]);
                    dR = dR + 1.0f; dI = dI + 1.0f;
                    f32x2 rr, ii; rr.x = frcp(dR.x); rr.y = frcp(dR.y); ii.x = frcp(dI.x); ii.y = frcp(dI.y);
                    const f32x2 la = rr * (-sp8);
                    f32x2 av; av.x = __builtin_amdgcn_exp2f(la.x); av.y = __builtin_amdgcn_exp2f(la.y);
                    const f32x2 t2 = (1.0f - av) * (av + 1.0f);
                    f32x2 bm; bm.x = __builtin_amdgcn_sqrtf(t2.x); bm.y = __builtin_amdgcn_sqrtf(t2.y);
                    f32x2 xc; xc.x = SB[t0_]; xc.y = SB[t1_];
                    const f32x2 bo = (bm * ii) * xc;
                    SA[t0_] = av.x; SA[t1_] = av.y; SB[t0_] = bo.x; SB[t1_] = bo.y; }
                __syncthreads();
                {   const int seg = tid >> 5, n = tid & 31;
                    float av[16], bv[16];
                    const int sbase = (dir ? 255 - 16 * seg : 16 * seg) * 33 + n, sstr = dir ? -33 : 33;
#pragma unroll
                    for (int i = 0; i < 16; ++i) { av[i] = SA[sbase + i * sstr]; bv[i] = SB[sbase + i * sstr]; }
                    float A = 1.f, Bv = 0.f;
#pragma unroll
                    for (int i = 0; i < 16; ++i) { Bv = av[i] * Bv + bv[i]; A *= av[i]; }
                    SEGA[seg * 32 + n] = A; SEGB[seg * 32 + n] = Bv;
                    __syncthreads();
                    float sa_[15], sb_[15];
#pragma unroll
                    for (int s = 0; s < 15; ++s) { sa_[s] = SEGA[s * 32 + n]; sb_[s] = SEGB[s * 32 + n]; }
                    float h = CAR[(ci & 1) * 32 + n];
#pragma unroll
                    for (int s = 0; s < 15; ++s) { const bool on = s < seg; const float a_ = on ? sa_[s] : 1.f, b_ = on ? sb_[s] : 0.f; h = a_ * h + b_; }
#pragma unroll
                    for (int i = 0; i < 16; ++i) { h = av[i] * h + bv[i]; SB[sbase + i * sstr] = h; }
                    if (seg == 15) CAR[((ci + 1) & 1) * 32 + n] = h;
                }
                __syncthreads();
#pragma unroll
                for (int i2 = 0; i2 < 2; ++i2) { const int idx = tid + 512 * i2, tt = idx >> 2, c8 = (idx & 3) * 8; const size_t m = (size_t)b * SEQ + t0 + tt;
                    float hv[8];
#pragma unroll
                    for (int i = 0; i < 8; ++i) hv[i] = SB[tt * 33 + c8 + i];
                    if (dir == 0) { v4u w; w.x = cvt_pk_bf16(hv[0], hv[1]); w.y = cvt_pk_bf16(hv[2], hv[3]); w.z = cvt_pk_bf16(hv[4], hv[5]); w.w = cvt_pk_bf16(hv[6], hv[7]);
                        *(v4u*)(HF + m * 1024 + oc0 + c8) = w; }
                    else { const v4u f = hfv[i2], gt = gtv[i2];
                        const f32x2 p0 = (mk2(hv[0], hv[1]) + mk2(bflo(f.x), bfhi(f.x))) * fgelu2(mk2(bflo(gt.x), bfhi(gt.x)));
                        const f32x2 p1 = (mk2(hv[2], hv[3]) + mk2(bflo(f.y), bfhi(f.y))) * fgelu2(mk2(bflo(gt.y), bfhi(gt.y)));
                        const f32x2 p2 = (mk2(hv[4], hv[5]) + mk2(bflo(f.z), bfhi(f.z))) * fgelu2(mk2(bflo(gt.z), bfhi(gt.z)));
                        const f32x2 p3 = (mk2(hv[6], hv[7]) + mk2(bflo(f.w), bfhi(f.w))) * fgelu2(mk2(bflo(gt.w), bfhi(gt.w)));
                        v4u w; w.x = cvt_pk_bf16(p0.x, p0.y); w.y = cvt_pk_bf16(p1.x, p1.y); w.z = cvt_pk_bf16(p2.x, p2.y); w.w = cvt_pk_bf16(p3.x, p3.y);
                        *(v4u*)(MIX + m * 1024 + oc0 + c8) = w; }
                }
            }
            __syncthreads();
        }
    }
}
#define RLX_AGENT __ATOMIC_RELAXED, __HIP_MEMORY_SCOPE_AGENT
#define XB_TMO      128
#define XB_XCNT(j)  (256  + 64 * (j))
#define XB_XSUB(j)  (1280 + 64 * (j))
#define XB_XGEN(j)  (2304 + 64 * (j))
#define XB_TOP      3328
#define XB_TOPGEN   3392
#define XCD_BAR_WORDS 3456
#define XB_SPIN_CAP (1u << 18)

__device__ __forceinline__ unsigned xb_ld(unsigned* p)              { return __hip_atomic_load(p, __ATOMIC_RELAXED, __HIP_MEMORY_SCOPE_AGENT); }
__device__ __forceinline__ unsigned xb_add(unsigned* p, unsigned v) { return __hip_atomic_fetch_add(p, v, __ATOMIC_RELAXED, __HIP_MEMORY_SCOPE_AGENT); }
__device__ __forceinline__ unsigned xb_xcc_id() { return (unsigned)__builtin_amdgcn_s_getreg((3 << 11) | 20) & 0xFu; }
#define XB_SPIN(cond, bar) do { unsigned _sp = 0; while (cond) { __builtin_amdgcn_s_sleep(1); \
    if ((++_sp & 255u) == 0u) { if (xb_ld(&(bar)[XB_TMO])) break; if (_sp > XB_SPIN_CAP) { atomicAdd(&(bar)[XB_TMO], 1u); break; } } } } while (0)

struct XcdBarrier {
    unsigned* bar; unsigned x;
    volatile LAS unsigned* st;
};

__device__ __forceinline__ XcdBarrier xcd_barrier_post(unsigned* bar, volatile LAS unsigned* st) {
    XcdBarrier b; b.bar = bar; b.x = xb_xcc_id(); b.st = st;
    if (threadIdx.x == 0) (void)xb_add(&bar[XB_XCNT(b.x)], 1u);
    return b;
}
__device__ __forceinline__ void xcd_barrier_complete(unsigned* bar, unsigned x, unsigned& nloc, unsigned& nx) {
    const unsigned G = gridDim.x * gridDim.y * gridDim.z;
    unsigned sum, cnt, mine, sp = 0u;
    for (;;) {
        sum = 0u; cnt = 0u; mine = 0u;
#pragma unroll
        for (unsigned j = 0; j < 16; ++j) { const unsigned c = xb_ld(&bar[XB_XCNT(j)]); sum += c; cnt += (c > 0u) ? 1u : 0u; mine = (j == x) ? c : mine; }
        if (sum == G) break;
        __builtin_amdgcn_s_sleep(1);
        if ((++sp & 255u) == 0u) { if (xb_ld(&bar[XB_TMO])) break; if (sp > XB_SPIN_CAP) { atomicAdd(&bar[XB_TMO], 1u); break; } }
    }
    nloc = mine > 0u ? mine : 1u; nx = cnt > 0u ? cnt : 1u;
}

__device__ __forceinline__ void xcd_barrier(const XcdBarrier& b) {
    asm volatile("s_waitcnt vmcnt(0)" ::: "memory");
    __syncthreads();
    if (threadIdx.x == 0) {
        unsigned* bar = b.bar;
        __builtin_amdgcn_s_waitcnt(0);
        unsigned nloc = b.st[0], nx = b.st[1];
        if (nloc == 0u) { xcd_barrier_complete(bar, b.x, nloc, nx); b.st[0] = nloc; b.st[1] = nx; }
        const unsigned old = xb_add(&bar[XB_XSUB(b.x)], 1u);
        const unsigned gen = old / nloc;
        if (old + 1u == (gen + 1u) * nloc) {
            __builtin_amdgcn_fence(__ATOMIC_RELEASE, "agent");
            asm volatile("s_waitcnt vmcnt(0)" ::: "memory");
            const unsigned og = xb_add(&bar[XB_TOP], 1u);
            const unsigned tg = og / nx;
            if (og + 1u == (tg + 1u) * nx) xb_add(&bar[XB_TOPGEN], 1u);
            else XB_SPIN(xb_ld(&bar[XB_TOPGEN]) == tg, bar);
            __builtin_amdgcn_fence(__ATOMIC_ACQUIRE, "agent");
            xb_add(&bar[XB_XGEN(b.x)], 1u);
            asm volatile("s_waitcnt vmcnt(0)" ::: "memory");
        } else {
            XB_SPIN(xb_ld(&bar[XB_XGEN(b.x)]) == gen, bar);
            __builtin_amdgcn_fence(__ATOMIC_ACQUIRE, "agent");
            asm volatile("s_waitcnt vmcnt(0)" ::: "memory");
        }
    }
    __syncthreads();
}
struct Args { const float* in[31]; float* out; unsigned char* ws; int ph_lo, ph_hi; };
enum { K_P0 = 0, K_P0B, K_INPROJ, K_S5E, K_ATTN, K_S5Y, K_GLU, K_RGLRU, K_OUTPROJ, K_MLP1, K_MLP2, K_FINAL };
constexpr int NPHASE = 29;
#ifndef DUP_PH
#define DUP_PH (-1)
#define NDUP 0
#endif
constexpr int PTAB_OFF = 146432, DESC_OFF = 146432 + 512, MISC_OFF = 146432 + 768;
typedef unsigned long long u64;
__device__ __forceinline__ u64 ldptr(const LAS u64* t, int i) { const u64 v = t[i]; const unsigned lo = __builtin_amdgcn_readfirstlane((unsigned)v), hi = __builtin_amdgcn_readfirstlane((unsigned)(v >> 32)); return ((u64)hi << 32) | lo; }
#define INP(i) ((const float*)ldptr(PTAB, (i)))
#define WSP(T, off) ((T*)(ws + (off)))

__device__ __forceinline__ void shw_item(int it, const LAS u64* PTAB, unsigned char* ws, LAS unsigned char* lds, int tid) {
    LAS float* Al = (LAS float*)lds; LAS float* red = Al + 8192;
    int r = it, ll = 0, n1b = 20;
    for (ll = 0; ll < 4; ++ll) { n1b = (ll & 1) ? 32 : 20; if (r < n1b + 64) break; r -= n1b + 64; }
    const bool first = r < n1b; const int cbk = first ? r : r - n1b;
    const float* shp = WSP(float, WS_MOD) + (size_t)ll * 8 * 6144 + (first ? 0 : 3072);
    __syncthreads();
    for (int i = tid; i < 8192; i += NTHR) Al[i] = shp[(size_t)(i >> 10) * 6144 + (i & 1023)];
    __syncthreads();
    const float* W; int ldw; float* o; int ldo;
    if (first) { if (ll & 1) { W = INP(22) + (size_t)(ll >> 1) * 1024 * 2048; ldw = 2048; } else { W = INP(8) + (size_t)(ll >> 1) * 1024 * 1280; ldw = 1280; } o = WSP(float, WS_SHW1) + (size_t)ll * 8 * 2048; ldo = 2048; }
    else { W = INP(5) + (size_t)ll * 1024 * 4096; ldw = 4096; o = WSP(float, WS_SHW2) + (size_t)ll * 8 * 4096; ldo = 4096; }
    skinny_gemm(Al, red, W, ldw, cbk * 64, o, ldo, nullptr, tid);
}

__global__ void __launch_bounds__(NTHR) fwd_mega(Args args) {
    extern __shared__ __attribute__((aligned(16))) unsigned char lds_raw[];
    LAS unsigned char* lds0 = (LAS unsigned char*)lds_raw;
    cg::grid_group grid = cg::this_grid();
    if (threadIdx.x == 0) { LAS u64* PT0 = (LAS u64*)(lds0 + PTAB_OFF);
#pragma unroll
        for (int i = 0; i < 31; ++i) PT0[i] = (u64)args.in[i];
        PT0[31] = (u64)args.out; PT0[32] = (u64)args.ws;
    }
    if (threadIdx.x < 2) ((LAS unsigned*)(lds0 + MISC_OFF))[threadIdx.x] = 0u;
    __syncthreads();
    const int ph_lo = args.ph_lo, ph_hi = args.ph_hi;
    const XcdBarrier xbar = xcd_barrier_post((unsigned*)args.ws, (volatile LAS unsigned*)(lds0 + MISC_OFF));
    if (args.ph_hi < 0) grid.sync();

    if (ph_lo == 0) {
        const int tid = otid(), lane = tid & 63, wave = __builtin_amdgcn_readfirstlane(tid >> 6);
        const int G = gridDim.x, bid = blockIdx.x;
        const int vcu = (G % 8 == 0) ? (bid % 8) * (G / 8) + bid / 8 : bid;
        const int gw = vcu * NWAVES + wave, NGW = G * NWAVES;
        LAS unsigned char* lds = lds0; LAS u64* PTAB = (LAS u64*)(lds + PTAB_OFF);
        unsigned char* ws = (unsigned char*)ldptr(PTAB, 32);
        if (bid == 0) rope_table(WSP(f32x2, WS_ROPE), tid);

            for (int it = G - 1 - bid; it < 64; it += G) { const int ee = it >> 5, g = it & 31;
                s5_tables(ee, g, INP(9), INP(10), INP(11), INP(12), INP(13), INP(14), INP(15), WSP(bf16_t, WS_TT) + (size_t)ee * TT_LAYER, WSP(bf16_t, WS_PT) + (size_t)ee * PT_LAYER, WSP(f32x2, WS_A32) + ee * 4096, lds, tid); }
            {   LAS float* Al = (LAS float*)lds; LAS float* red = Al + 8192;
                bool loaded = false;
                const int nmw = (G > 128) ? G - 64 : G;
                for (int it = (bid < nmw ? bid : 4 * 96); it < 4 * 96; it += nmw) {
                    if (!loaded) { const float* cvec = INP(1); for (int i = tid; i < 8192; i += NTHR) { const float v = cvec[i]; Al[i] = v / (1.0f + __expf(-v)); } __syncthreads(); loaded = true; }
                    const int ll = it / 96, cbk = it % 96;
                    skinny_gemm(Al, red, INP(3) + (size_t)ll * 1024 * 6144, 6144, cbk * 64, WSP(float, WS_MOD) + (size_t)ll * 8 * 6144, 6144, INP(4) + (size_t)ll * 6144, tid, true);
                }
                __syncthreads();
            }
            {   LAS float* scr = (LAS float*)(lds + wave * 16640);
#pragma unroll 1
                for (int mi = 0; mi < 18; ++mi) {
                    const float* W; bf16_t* WT; int K, N;
                    if (mi < 2)       { W = INP(8) + (size_t)mi * 1024 * 1280; WT = WSP(bf16_t, WS_WHIN) + (size_t)mi * 1280 * 1024; K = 1024; N = 1280; }
                    else if (mi < 4)  { W = INP(21) + (size_t)(mi - 2) * 1024 * 1024; WT = WSP(bf16_t, WS_WHOUT) + (size_t)(mi - 2) * 1024 * 1024; K = 1024; N = 1024; }
                    else if (mi < 6)  { W = INP(17) + (size_t)(mi - 4) * 512 * 512; WT = WSP(bf16_t, WS_WGLU) + (size_t)(mi - 4) * 512 * 512; K = 512; N = 512; }
                    else if (mi < 8)  { W = INP(22) + (size_t)(mi - 6) * 1024 * 2048; WT = WSP(bf16_t, WS_WRIN) + (size_t)(mi - 6) * 2048 * 1024; K = 1024; N = 2048; }
                    else if (mi < 10) { W = INP(30) + (size_t)(mi - 8) * 1024 * 1024; WT = WSP(bf16_t, WS_WROUT) + (size_t)(mi - 8) * 1024 * 1024; K = 1024; N = 1024; }
                    else if (mi < 14) { W = INP(5) + (size_t)(mi - 10) * 1024 * 4096; WT = WSP(bf16_t, WS_W1) + (size_t)(mi - 10) * 4096 * 1024; K = 1024; N = 4096; }
                    else              { W = INP(6) + (size_t)(mi - 14) * 4096 * 1024; WT = WSP(bf16_t, WS_W2) + (size_t)(mi - 14) * 1024 * 4096; K = 4096; N = 1024; }
                    const int nit = (K / 64) * (N / 64);
                    const bool ntw = (mi >= 2 && mi < 6) || (mi >= 8 && mi < 10) || mi >= 14;
                    const bool tsplit = G > 128;
                    const bool smallm = (mi >= 2 && mi < 6) || (mi >= 8 && mi < 10), tabwg = bid >= G - 64;
                    const int itb = tsplit ? (tabwg ? (bid - (G - 64)) * NWAVES + wave : bid * NWAVES + wave) : gw, its = tsplit ? (tabwg ? 64 * NWAVES : (G - 64) * NWAVES) : NGW;
                    if (!tsplit || (tabwg == smallm)) {
                        f32x4 va[16], vb[16];
                        int it = itb;
                        if (it < nit) p0_transpose_load(va, W, N, it, lane, ntw);
                        while (it < nit) {
                            const int itn = it + its;
                            if (itn < nit) p0_transpose_load(vb, W, N, itn, lane, ntw);
                            p0_transpose_store(va, K, N, WT, scr, it, lane);
#pragma unroll
                            for (int i = 0; i < 16; ++i) va[i] = vb[i];
                            it = itn;
                        }
                    }
                }
            }
    }
#pragma unroll 1
    for (int step = (ph_lo > 1 ? ph_lo : 1); step < ph_hi + NDUP; ++step) {
        const int ph = (DUP_PH < 0 || step <= DUP_PH) ? step : (step <= DUP_PH + NDUP ? DUP_PH : step - NDUP);
        const bool merged = (gridDim.x == 256);
        if (merged && (ph == 5 || ph == 18)) continue;
        if (step > ph_lo) xcd_barrier(xbar);
        const int tid = otid(), lane = tid & 63, wave = __builtin_amdgcn_readfirstlane(tid >> 6);
        unsigned lb_ = 0; asm volatile("" : "+s"(lb_));
        LAS unsigned char* lds = lds0 + lb_; LAS u64* PTAB = (LAS u64*)(lds + PTAB_OFF); LAS u64* DESC = (LAS u64*)(lds + DESC_OFF);
        int G = gridDim.x, bid = blockIdx.x;
        asm volatile("" : "+s"(G), "+s"(bid));
        const int vcu = (G % 8 == 0) ? (bid % 8) * (G / 8) + bid / 8 : bid;
        const int gw = vcu * NWAVES + wave, NGW = G * NWAVES;
        u64 wsv_ = ldptr(PTAB, 32), outv_ = ldptr(PTAB, 31);
        asm volatile("" : "+s"(wsv_), "+s"(outv_));
        unsigned char* ws = (unsigned char*)wsv_;
        float* out = (float*)outv_;
        int kind, l = 0;
        if (ph == 0) kind = K_P0; else if (ph == 1) kind = K_P0B; else if (ph == NPHASE - 1) kind = K_FINAL;
        else { int q = ph - 2, sub; if (q < 8) { l = 0; sub = q; } else if (q < 13) { l = 1; sub = q - 8; } else if (q < 21) { l = 2; sub = q - 13; } else { l = 3; sub = q - 21; }
            if ((l & 1) == 0) kind = (sub == 0) ? K_INPROJ : (sub == 1) ? K_S5E : (sub == 2) ? K_ATTN : (sub == 3) ? K_S5Y : (sub == 4) ? K_GLU : (sub == 5) ? K_OUTPROJ : (sub == 6) ? K_MLP1 : K_MLP2;
            else kind = (sub == 0) ? K_INPROJ : (sub == 1) ? K_RGLRU : (sub == 2) ? K_OUTPROJ : (sub == 3) ? K_MLP1 : K_MLP2; }
        const int e = l >> 1;
        const bool even = (l & 1) == 0;

        if (kind == K_P0B) {
            {   for (int it = bid; it < 360; it += G) shw_item(it, PTAB, ws, lds, tid);
            }
            {   const float* x = INP(0); const float* norm_w = INP(2); const float* MOD = WSP(float, WS_MOD); bf16_t* HW = WSP(bf16_t, WS_HW); float* ROWSS = WSP(float, WS_ROWSS);
                const int nheavy = (360 > G) ? (360 - G < G ? 360 - G : G) : 0;
                const int myshare = (bid < nheavy) ? 1 : 2, shbase = (bid < nheavy) ? bid : nheavy + 2 * (bid - nheavy), nshare = nheavy + 2 * (G - nheavy);
                for (int sh = 0; sh < myshare; ++sh)
                for (int m0 = 2 * ((shbase + sh) * NWAVES + wave); m0 < MTOK; m0 += 2 * nshare * NWAVES) {
                    const int b = m0 >> 12;
                    f32x4 v[2][4];
#pragma unroll
                    for (int rr = 0; rr < 2; ++rr)
#pragma unroll
                        for (int j = 0; j < 4; ++j) v[rr][j] = ((const f32x4*)(x + (size_t)(m0 + rr) * DM) + lane)[64 * j];
#pragma unroll
                    for (int rr = 0; rr < 2; ++rr) { const int m = m0 + rr; float ss = 0.f;
#pragma unroll
                        for (int j = 0; j < 4; ++j) { const f32x4 vv = v[rr][j]; ss += (vv[0] * vv[0] + vv[1] * vv[1]) + (vv[2] * vv[2] + vv[3] * vv[3]);
                            const int col = 4 * lane + 256 * j;
                            const f32x4 nw = *(const f32x4*)(norm_w + col), sc = *(const f32x4*)(MOD + (size_t)b * 6144 + 1024 + col);
                            const f32x4 hw = vv * nw * (sc + 1.0f);
                            v2u w; w.x = cvt_pk_bf16(hw[0], hw[1]); w.y = cvt_pk_bf16(hw[2], hw[3]); *(v2u*)(HW + (size_t)m * DM + col) = w; }
                        ss = wave_sum(ss, lane);
                        if (lane < 16) ROWSS[(size_t)m * 16 + lane] = lane == 0 ? ss : 0.f; }
                }
            }
        } else if (kind == K_FINAL) {
            const float* final_w = INP(7); const float* ROWSS = WSP(float, WS_ROWSS); const bf16_t* FIN = WSP(bf16_t, WS_TT);
            for (int m = gw; m < MTOK; m += NGW) {
                const float v = lane < 16 ? ROWSS[(size_t)m * 16 + lane] : 0.f;
                const v4u hraw0 = *((const v4u*)(FIN + (size_t)m * DM) + lane), hraw1 = *((const v4u*)(FIN + (size_t)m * DM) + 64 + lane);
                const float ss = wave_sum(v, lane);
                const float rstd = 1.0f / sqrtf(ss * (1.0f / 1024.0f) + 1e-6f);
#pragma unroll
                for (int j = 0; j < 2; ++j) { const v4u w = j ? hraw1 : hraw0; const int col = 8 * lane + 512 * j;
                    const f32x4 f0 = *(const f32x4*)(final_w + col), f1 = *(const f32x4*)(final_w + col + 4);
                    const f32x4 h0 = (f32x4){bflo(w.x), bfhi(w.x), bflo(w.y), bfhi(w.y)}, h1 = (f32x4){bflo(w.z), bfhi(w.z), bflo(w.w), bfhi(w.w)};
                    *(f32x4*)(out + (size_t)m * DM + col) = h0 * rstd * f0; *(f32x4*)(out + (size_t)m * DM + col + 4) = h1 * rstd * f1; }
            }
        } else if (kind == K_RGLRU) {
            rglru_phase(e, WSP(bf16_t, R_Z), WSP(bf16_t, R_HF), WSP(bf16_t, R_MIX), INP(23), INP(24), INP(25), INP(26), INP(27), INP(28), INP(29), lds, tid, bid, G);
        } else if (kind == K_ATTN) {
#define RUN_ATTN() do { const attn_body::AttnTensors AT{(const attn_body::bf16*)WSP(bf16_t, R_QP), (const attn_body::bf16*)WSP(bf16_t, R_KP), (const attn_body::bf16*)WSP(bf16_t, R_V), (attn_body::bf16*)(WSP(bf16_t, R_MIX) + 512)}; \
                const attn_body::StaticOrder SO(G, bid); attn_body::attn_phase<attn_body::StaticOrder>((char*)lds_raw + lb_, AT, SO); __syncthreads(); } while (0)
#define RUN_S5Y() do { const int pm_ = vcu >> 1, g5_ = pm_ >> 2, b0_ = 2 * (pm_ & 3);     \
                s5_scan_phase(WSP(float, R_E), WSP(bf16_t, R_AP), WSP(f32x2, WS_A32) + e * 4096, lds, tid, b0_ * 32 + g5_, b0_ * 32 + g5_ + 33, 32); \
                asm volatile("s_waitcnt vmcnt(0)" ::: "memory"); __syncthreads(); \
                pg8::Gemm g{}; pg8::Sched S{}; pg8::Epi E{}; \
                S.G = G; S.c = vcu; S.mode = 2; S.nM = 128; S.nN = 2; S.nwg = 256; E.d = DESC; E.mode = pg8::EM_S5Y; \
                g.A = WSP(bf16_t, R_AP); g.lda = 768; g.K = 768; g.perm = 1; g.Bt = WSP(bf16_t, WS_TT) + (size_t)e * TT_LAYER; g.ldb = 768; \
                if (tid == 0) { DESC[2] = (u64)WSP(bf16_t, R_G); DESC[13] = (u64)WSP(bf16_t, R_AP); DESC[12] = (u64)(INP(16) + e * 512); } \
                __syncthreads(); pg8::gemm_phase<pg8::Epi, pg8::Sched, true, true>(lds, g, S, E); __syncthreads(); } while (0)
            if (!merged) {
                s5_scan_phase(WSP(float, R_E), WSP(bf16_t, R_AP), WSP(f32x2, WS_A32) + e * 4096, lds, tid, bid, 256, G);
                RUN_ATTN();
            } else if ((vcu & 2) == 0) { RUN_S5Y(); RUN_ATTN(); }
            else { RUN_ATTN(); RUN_S5Y(); }
#undef RUN_ATTN
#undef RUN_S5Y
        } else {
            pg8::Gemm g{}; pg8::Sched S{}; pg8::Epi E{};
            S.G = G; S.c = bid; S.mode = 0; S.nM = 128; E.d = DESC;
            const float* mod_l = WSP(float, WS_MOD) + (size_t)l * 8 * 6144;
            u64 dv[16];
#pragma unroll
            for (int i = 0; i < 16; ++i) dv[i] = 0;
            if (kind == K_INPROJ) {
                g.A = WSP(bf16_t, WS_HW); g.lda = 1024; g.K = 1024; g.perm = 1; g.ldb = 1024;
                dv[0] = (u64)WSP(float, WS_ROWSS); dv[1] = (u64)(WSP(float, WS_SHW1) + (size_t)l * 8 * 2048); dv[14] = 2048;
                if (even) { g.Bt = WSP(bf16_t, WS_WHIN) + (size_t)e * 1280 * 1024; S.nN = (G == 256) ? 4 : 5; E.mode = pg8::EM_INA; dv[2] = (u64)WSP(bf16_t, R_AP); dv[3] = (u64)WSP(bf16_t, R_Q); dv[4] = (u64)WSP(bf16_t, R_K); dv[5] = (u64)WSP(bf16_t, R_V); }
                else { g.Bt = WSP(bf16_t, WS_WRIN) + (size_t)e * 2048 * 1024; S.nN = 8; E.mode = pg8::EM_INB; dv[2] = (u64)WSP(bf16_t, R_Z); }
            } else if (kind == K_S5E) {
                g.A = WSP(bf16_t, R_AP); g.lda = 768; g.K = 512; g.perm = 0; g.Bt = WSP(bf16_t, WS_PT) + (size_t)e * PT_LAYER; g.ldb = 512;
                S.mode = 1; S.c = vcu; S.nN = 1; E.mode = pg8::EM_S5E; dv[6] = (u64)WSP(float, R_E);
                if (G == 256 && vcu >= 128) {
                    g.A = WSP(bf16_t, WS_HW); g.lda = 1024; g.K = 1024; g.perm = 1; g.Bt = WSP(bf16_t, WS_WHIN) + (size_t)e * 1280 * 1024; g.ldb = 1024;
                    S.mode = 3; E.mode = pg8::EM_INA; dv[6] = 0;
                    dv[0] = (u64)WSP(float, WS_ROWSS); dv[1] = (u64)(WSP(float, WS_SHW1) + (size_t)l * 8 * 2048); dv[14] = 2048;
                    dv[2] = (u64)WSP(bf16_t, R_AP); dv[3] = (u64)WSP(bf16_t, R_Q); dv[4] = (u64)WSP(bf16_t, R_K); dv[5] = (u64)WSP(bf16_t, R_V);
                }
            } else if (kind == K_S5Y) {
                g.A = WSP(bf16_t, R_AP); g.lda = 768; g.K = 768; g.perm = 1; g.Bt = WSP(bf16_t, WS_TT) + (size_t)e * TT_LAYER; g.ldb = 768;
                S.mode = 2; S.c = vcu; S.nN = 2; E.mode = pg8::EM_S5Y; dv[2] = (u64)WSP(bf16_t, R_G); dv[13] = (u64)WSP(bf16_t, R_AP); dv[12] = (u64)(INP(16) + e * 512);
            } else if (kind == K_GLU) {
                g.A = WSP(bf16_t, R_G); g.lda = 512; g.K = 512; g.perm = 1; g.Bt = WSP(bf16_t, WS_WGLU) + (size_t)e * 512 * 512; g.ldb = 512;
                S.nN = 2; E.mode = pg8::EM_GLU; dv[2] = (u64)WSP(bf16_t, R_MIX); dv[13] = (u64)WSP(bf16_t, R_G); dv[12] = (u64)(INP(18) + e * 512);
            } else if (kind == K_OUTPROJ) {
                g.A = WSP(bf16_t, R_MIX); g.lda = 1024; g.K = 1024; g.perm = 1; g.Bt = (even ? WSP(bf16_t, WS_WHOUT) : WSP(bf16_t, WS_WROUT)) + (size_t)e * 1024 * 1024; g.ldb = 1024;
                S.nN = 4; E.mode = pg8::EM_RES; dv[6] = (u64)out; dv[7] = (l == 0) ? (u64)INP(0) : (u64)out; dv[15] = (l == 0) ? 1 : 0; dv[8] = (u64)(mod_l + 2048);
                dv[9] = (u64)(INP(2) + (size_t)(l * 2 + 1) * 1024); dv[10] = (u64)(mod_l + 4096); dv[2] = (u64)WSP(bf16_t, WS_HW); dv[11] = (u64)WSP(float, WS_ROWSS);
            } else if (kind == K_MLP1) {
                g.A = WSP(bf16_t, WS_HW); g.lda = 1024; g.K = 1024; g.perm = 1; g.Bt = WSP(bf16_t, WS_W1) + (size_t)l * 4096 * 1024; g.ldb = 1024;
                S.nN = 16; E.mode = pg8::EM_MLP1; dv[0] = (u64)WSP(float, WS_ROWSS); dv[1] = (u64)(WSP(float, WS_SHW2) + (size_t)l * 8 * 4096); dv[14] = 4096; dv[2] = (u64)WSP(bf16_t, R_HID);
            } else {
                g.A = WSP(bf16_t, R_HID); g.lda = 4096; g.K = 4096; g.perm = 1; g.Bt = WSP(bf16_t, WS_W2) + (size_t)l * 1024 * 4096; g.ldb = 4096;
                S.nN = 4; E.mode = pg8::EM_RES; dv[6] = (l == 3) ? (u64)WSP(bf16_t, WS_TT) : (u64)out; dv[7] = (u64)out; dv[8] = (u64)(mod_l + 5120);
                if (l < 3) { dv[9] = (u64)(INP(2) + (size_t)((l + 1) * 2) * 1024); dv[10] = (u64)(WSP(float, WS_MOD) + (size_t)(l + 1) * 8 * 6144 + 1024); }
                dv[2] = (u64)WSP(bf16_t, WS_HW); dv[11] = (u64)WSP(float, WS_ROWSS);
            }
            __syncthreads();
            if (tid == 0) {
#pragma unroll
                for (int i = 0; i < 16; ++i) DESC[i] = dv[i];
            }
            __syncthreads();
            S.nwg = (S.mode == 1) ? 128 : ((S.mode == 2 || S.mode == 3) ? 256 : S.nM * S.nN);
#ifndef STAG_TICKS
#define STAG_TICKS 0
#endif
#ifndef STAG_RES
#define STAG_RES 0
#endif
            {
                const int stg = (kind == K_OUTPROJ || kind == K_MLP2) ? STAG_RES : (kind == K_MLP1 ? STAG_TICKS : 0);
                const int grp = (bid >> 3) & 3;
                if (stg > 0 && grp) { const u64 t0 = __builtin_amdgcn_s_memrealtime(); while (__builtin_amdgcn_s_memrealtime() - t0 < (u64)(grp * stg)) __builtin_amdgcn_s_sleep(8); }
            }
            pg8::gemm_phase<pg8::Epi, pg8::Sched, true, true>(lds, g, S, E);
            if (kind == K_S5E) { __syncthreads(); asm volatile("s_waitcnt vmcnt(0)" ::: "memory"); __syncthreads();
                const bool kvs = (G == 256);
                const bool qown = kvs && vcu < 128, kown = kvs && vcu >= 128;
                qkprep_phase(WSP(bf16_t, R_Q), WSP(bf16_t, R_K), WSP(bf16_t, R_QP), WSP(bf16_t, R_KP), INP(19) + e * 64, INP(20) + e * 64, WSP(f32x2, WS_ROPE), lds, tid,
                             kvs ? (qown ? vcu * NWAVES + wave : MTOK) : gw, kvs ? 128 * NWAVES : NGW,
                             kvs ? MTOK : MTOK + MTOK / 4, kown ? (vcu - 128) * 64 : 0, kown ? (vcu - 128) * 64 + 64 : 0); }
        }
    }
}

extern "C" void kernel_launch(void* const* d_in, const int* in_sizes, int n_in, void* d_out, int out_size, void* d_ws, size_t ws_size, hipStream_t stream) {
    static int grid = 0;
    if (grid == 0) {
        int dev = 0, cus = 0, per_cu = 0;
        (void)hipGetDevice(&dev); (void)hipDeviceGetAttribute(&cus, hipDeviceAttributeMultiprocessorCount, dev);
        (void)hipFuncSetAttribute((const void*)fwd_mega, hipFuncAttributeMaxDynamicSharedMemorySize, LDS_BYTES);
        (void)hipOccupancyMaxActiveBlocksPerMultiprocessor(&per_cu, (const void*)fwd_mega, NTHR, LDS_BYTES);
        if (per_cu != 1) per_cu = 1;
        (void)hipGetLastError();
        grid = cus * per_cu;
        if (ws_size < WS_END) fprintf(stderr, "kernel_launch: workspace too small: %zu < %zu\n", ws_size, (size_t)WS_END);
        if (n_in != 31) fprintf(stderr, "kernel_launch: expected 31 inputs, got %d\n", n_in);
    }
    (void)hipMemsetAsync(d_ws, 0, 16384, stream);
    Args a{};
    for (int i = 0; i < 31; ++i) a.in[i] = (const float*)d_in[i];
    a.out = (float*)d_out; a.ws = (unsigned char*)d_ws; a.ph_lo = 0; a.ph_hi = NPHASE;
    void* kargs[] = {&a};
    hipError_t err = hipLaunchCooperativeKernel((const void*)fwd_mega, dim3(grid), dim3(NTHR), kargs, LDS_BYTES, stream);
    if (err != hipSuccess) fprintf(stderr, "cooperative launch failed: %s (grid %d)\n", hipGetErrorString(err), grid);
}
```

```cpp
#include <hip/hip_runtime.h>
#include <hip/hip_bf16.h>
#include <hip/hip_cooperative_groups.h>
#include <cstdio>
#include <cstdint>
#include <cmath>
namespace cg = cooperative_groups;
__device__ __forceinline__ int otid() { int t = threadIdx.x; asm volatile("" : "+v"(t)); return t; }
__device__ __forceinline__ float shx(float v, int mask, int lane) { return __builtin_bit_cast(float, __builtin_amdgcn_ds_bpermute((lane ^ mask) << 2, __builtin_bit_cast(int, v))); }
namespace pg8 {
#define PG8_LAS __attribute__((address_space(3)))
typedef unsigned short bf16_t;
typedef short bf16x8 __attribute__((ext_vector_type(8)));
typedef float f32x4 __attribute__((ext_vector_type(4)));
typedef unsigned u32x4 __attribute__((ext_vector_type(4)));
constexpr int BM = 256, BK = 64, HALF = 128, HTB = HALF * BK * 2  , STAGE_BYTES = 8 * HTB, NXCD = 8, WGM = 4;

__host__ __device__ __forceinline__ int lds_byte(int r, int c) { const int st = (r >> 4) * 2 + (c >> 5), rr = r & 15, cc = c & 31, ob = rr * 64 + cc * 2; return st * 1024 + (ob ^ (((ob >> 9) & 1) << 5)); }
__host__ __device__ __forceinline__ void stage_rc(int b, int& R, int& C) { const int st = b / 1024, sb = b % 1024, swz = sb ^ (((sb >> 9) & 1) << 5); R = (st >> 1) * 16 + swz / 64; C = (st & 1) * 32 + (swz % 64) / 2; }
__host__ __device__ __forceinline__ int perm32(int rho) { const int n = rho >> 4, i = rho & 15; return 8 * (i >> 2) + 4 * n + (i & 3); }

struct Unit { int pm, pn; };
typedef unsigned u32x2 __attribute__((ext_vector_type(2)));
}
namespace pg8 {
struct Gemm { const bf16_t* A; const bf16_t* Bt; int lda, ldb, K, perm; };
__device__ __forceinline__ unsigned cvt_pk_bf16(float lo, float hi) { unsigned r; asm("v_cvt_pk_bf16_f32 %0, %1, %2" : "=v"(r) : "v"(lo), "v"(hi)); return r; }
__device__ __forceinline__ float bflo(unsigned w) { return __uint_as_float(w << 16); }
__device__ __forceinline__ float bfhi(unsigned w) { return __uint_as_float(w & 0xffff0000u); }
__device__ __forceinline__ float gelu_tanh(float x) { return x * __builtin_amdgcn_rcpf(1.0f + __builtin_amdgcn_exp2f(x * (-2.3022082f + -0.10294324f * x * x))); }
__device__ __forceinline__ float sigmoidf_(float x) { return __builtin_amdgcn_rcpf(1.0f + __builtin_amdgcn_exp2f(-1.4426950408889634f * x)); }

struct Sched { int mode, nM, nN, nwg, G, c;
    __device__ __forceinline__ bool next(int i, Unit& u) const {
        const long L = (long)i * G + c; if (L >= nwg) return false;
        if (mode == 0) {
            int wgid = (int)L; { const int q = nwg / NXCD, r = nwg % NXCD, xcd = wgid % NXCD, off = wgid / NXCD; wgid = (xcd < r ? xcd * (q + 1) : r * (q + 1) + (xcd - r) * q) + off; }
            const int nig = WGM * nN, gid = wgid / nig, fm = gid * WGM, gsz = (nM - fm) < WGM ? (nM - fm) : WGM;
            u.pm = fm + ((wgid % nig) % gsz); u.pn = (wgid % nig) / gsz;
        } else if (mode == 1) { u.pm = (int)L; u.pn = (int)L >> 2; }
        else if (mode == 3) { u.pm = (int)L - 128; u.pn = 4; }
        else { u.pm = (int)L >> 1; u.pn = (((int)L >> 3) << 1) + ((int)L & 1); }
        return true;
    }
    __device__ __forceinline__ void a_ready(const Unit&) const {}
    __device__ __forceinline__ void done(const Unit&) const {}
};

enum { EM_INA = 0, EM_INB = 1, EM_MLP1 = 2, EM_S5E = 3, EM_S5Y = 4, EM_GLU = 5, EM_RES = 6 };
struct Epi {
    static constexpr bool AFTER_DRAIN = false;
    int mode; const PG8_LAS unsigned long long* d;
    __device__ __forceinline__ unsigned long long P(int i) const { const unsigned long long v = d[i]; const unsigned lo = __builtin_amdgcn_readfirstlane((unsigned)v), hi = __builtin_amdgcn_readfirstlane((unsigned)(v >> 32)); return ((unsigned long long)hi << 32) | lo; }
    __device__ __forceinline__ void operator()(const f32x4 (&acc)[2][2][4][2], const Unit& u, int wr, int wc, int fr, int fq) const {
        if (mode <= EM_MLP1) {
            const float* rowss = (const float*)P(0); const float* shw = (const float*)P(1); const int ldshw = (int)P(14); bf16_t* o0 = (bf16_t*)P(2); bf16_t* o1 = (bf16_t*)P(3); bf16_t* o2 = (bf16_t*)P(4); bf16_t* o3 = (bf16_t*)P(5);
            const int bb = u.pm >> 4;
            const int colt = u.pn * BM + wc * 32 + 8 * fq;
            f32x4 sv[2][2];
#pragma unroll
            for (int bj = 0; bj < 2; ++bj)
#pragma unroll
                for (int n = 0; n < 2; ++n) sv[bj][n] = *(const f32x4*)(shw + (size_t)bb * ldshw + colt + bj * HALF + 4 * n);
            f32x4 pr[2][4];
#pragma unroll
            for (int ai = 0; ai < 2; ++ai)
#pragma unroll
                for (int m = 0; m < 4; ++m) pr[ai][m] = *((const f32x4*)(rowss + (size_t)(u.pm * BM + ai * HALF + wr * 64 + m * 16 + fr) * 16) + fq);
            float rsd[2][4];
#pragma unroll
            for (int ai = 0; ai < 2; ++ai)
#pragma unroll
                for (int m = 0; m < 4; ++m) { float ss = (pr[ai][m][0] + pr[ai][m][1]) + (pr[ai][m][2] + pr[ai][m][3]); ss += shx(ss, 16, fr + 16 * fq); ss += shx(ss, 32, fr + 16 * fq);
                    rsd[ai][m] = __builtin_amdgcn_rsqf(ss * (1.0f / 1024.0f) + 1e-6f); }
#pragma unroll
            for (int ai = 0; ai < 2; ++ai)
#pragma unroll
                for (int m = 0; m < 4; ++m) {
                    const int row = u.pm * BM + ai * HALF + wr * 64 + m * 16 + fr;
                    const float rstd = rsd[ai][m];
#pragma unroll
                    for (int bj = 0; bj < 2; ++bj) {
                        f32x4 v0 = acc[ai][bj][m][0] * rstd + sv[bj][0], v1 = acc[ai][bj][m][1] * rstd + sv[bj][1];
                        const int col = colt + bj * HALF;
                        bf16_t* dst;
                        if (mode == EM_MLP1) {
                            { const f32x4 z4 = (f32x4){0.f, 0.f, 0.f, 0.f}; const f32x4 a = __builtin_elementwise_max(v0, z4), b = __builtin_elementwise_max(v1, z4); v0 = a * a; v1 = b * b; }
                            dst = o0 + (size_t)row * 4096 + col;
                        } else if (mode == EM_INB) { dst = o0 + (size_t)row * 2048 + col; }
                        else {
                            if (u.pn < 2) { const int g = col >> 4, c0 = col & 15, s = row & 4095; dst = o0 + ((size_t)(g * 1024 + bb * 128 + (s >> 5)) * 768 + (s & 31) * 16 + c0); }
                            else if (u.pn < 4) dst = o1 + (size_t)row * 512 + (col - 512);
                            else if (bj == 0) dst = o2 + (size_t)row * 128 + (col - 1024);
                            else dst = o3 + (size_t)row * 128 + (col - 1152);
                        }
                        u32x4 w; w.x = cvt_pk_bf16(v0[0], v0[1]); w.y = cvt_pk_bf16(v0[2], v0[3]); w.z = cvt_pk_bf16(v1[0], v1[1]); w.w = cvt_pk_bf16(v1[2], v1[3]);
                        *(u32x4*)dst = w;
                    }
                }
        } else if (mode == EM_S5E) {
            float* of = (float*)P(6);
#pragma unroll
            for (int ai = 0; ai < 2; ++ai)
#pragma unroll
                for (int m = 0; m < 4; ++m) {
                    const int row = u.pm * BM + ai * HALF + wr * 64 + m * 16 + fr;
#pragma unroll
                    for (int bj = 0; bj < 2; ++bj)
#pragma unroll
                        for (int n = 0; n < 2; ++n) *(f32x4*)(of + (size_t)row * 256 + bj * HALF + wc * 32 + n * 16 + 4 * fq) = acc[ai][bj][m][n];
                }
        } else if (mode == EM_S5Y) {
            const float* vec = (const float*)P(12); const bf16_t* gin = (const bf16_t*)P(13); bf16_t* o0 = (bf16_t*)P(2);
            const int g = u.pn >> 1, pnl = u.pn & 1;
            const int c0 = 8 * (fq & 1);
            const f32x4 d0 = *(const f32x4*)(vec + g * 16 + c0), d1 = *(const f32x4*)(vec + g * 16 + c0 + 4);
#pragma unroll
            for (int ai = 0; ai < 2; ++ai) {
                u32x4 ua[2][4][2];
#pragma unroll
                for (int m = 0; m < 4; ++m)
#pragma unroll
                    for (int bj = 0; bj < 2; ++bj) ua[ai][m][bj] = *(const u32x4*)(gin + (size_t)(u.pm * BM + ai * HALF + wr * 64 + m * 16 + fr) * 768 + ((pnl * BM + bj * HALF + wc * 32 + 8 * fq) >> 4) * 16 + c0);
                asm volatile("" ::: "memory");
#pragma unroll
                for (int m = 0; m < 4; ++m) {
                    const int row = u.pm * BM + ai * HALF + wr * 64 + m * 16 + fr;
                    const int rg = row & 1023, b = rg >> 7, k = rg & 127;
#pragma unroll
                    for (int bj = 0; bj < 2; ++bj) {
                        const int nn = pnl * BM + bj * HALF + wc * 32 + 8 * fq, tl = nn >> 4;
                        const u32x4 uu = ua[ai][m][bj];
                        f32x4 v0 = acc[ai][bj][m][0], v1 = acc[ai][bj][m][1];
                        v0[0] += d0[0] * bflo(uu.x); v0[1] += d0[1] * bfhi(uu.x); v0[2] += d0[2] * bflo(uu.y); v0[3] += d0[3] * bfhi(uu.y);
                        v1[0] += d1[0] * bflo(uu.z); v1[1] += d1[1] * bfhi(uu.z); v1[2] += d1[2] * bflo(uu.w); v1[3] += d1[3] * bfhi(uu.w);
#pragma unroll
                        for (int j = 0; j < 4; ++j) { v0[j] = gelu_tanh(v0[j]); v1[j] = gelu_tanh(v1[j]); }
                        u32x4 w; w.x = cvt_pk_bf16(v0[0], v0[1]); w.y = cvt_pk_bf16(v0[2], v0[3]); w.z = cvt_pk_bf16(v1[0], v1[1]); w.w = cvt_pk_bf16(v1[2], v1[3]);
                        const size_t token = (size_t)b * 4096 + k * 32 + tl;
                        *(u32x4*)(o0 + token * 512 + g * 16 + c0) = w;
                    }
                }
            }
        } else if (mode == EM_GLU) {
            const float* vec = (const float*)P(12); const bf16_t* gin = (const bf16_t*)P(13); bf16_t* o0 = (bf16_t*)P(2);
            const int colt = u.pn * BM + wc * 32 + 8 * fq;
            f32x4 bv[2][2];
#pragma unroll
            for (int bj = 0; bj < 2; ++bj)
#pragma unroll
                for (int n = 0; n < 2; ++n) bv[bj][n] = *(const f32x4*)(vec + colt + bj * HALF + 4 * n);
#pragma unroll
            for (int ai = 0; ai < 2; ++ai) {
                u32x4 ga[2][4][2];
#pragma unroll
                for (int m = 0; m < 4; ++m)
#pragma unroll
                    for (int bj = 0; bj < 2; ++bj) ga[ai][m][bj] = *(const u32x4*)(gin + (size_t)(u.pm * BM + ai * HALF + wr * 64 + m * 16 + fr) * 512 + colt + bj * HALF);
                asm volatile("" ::: "memory");
#pragma unroll
                for (int m = 0; m < 4; ++m) {
                    const int row = u.pm * BM + ai * HALF + wr * 64 + m * 16 + fr;
#pragma unroll
                    for (int bj = 0; bj < 2; ++bj) {
                        const int col = colt + bj * HALF;
                        const u32x4 gg = ga[ai][m][bj];
                        f32x4 v0 = acc[ai][bj][m][0] + bv[bj][0], v1 = acc[ai][bj][m][1] + bv[bj][1];
                        v0[0] = bflo(gg.x) * sigmoidf_(v0[0]); v0[1] = bfhi(gg.x) * sigmoidf_(v0[1]); v0[2] = bflo(gg.y) * sigmoidf_(v0[2]); v0[3] = bfhi(gg.y) * sigmoidf_(v0[3]);
                        v1[0] = bflo(gg.z) * sigmoidf_(v1[0]); v1[1] = bfhi(gg.z) * sigmoidf_(v1[1]); v1[2] = bflo(gg.w) * sigmoidf_(v1[2]); v1[3] = bfhi(gg.w) * sigmoidf_(v1[3]);
                        u32x4 w; w.x = cvt_pk_bf16(v0[0], v0[1]); w.y = cvt_pk_bf16(v0[2], v0[3]); w.z = cvt_pk_bf16(v1[0], v1[1]); w.w = cvt_pk_bf16(v1[2], v1[3]);
                        *(u32x4*)(o0 + (size_t)row * 1024 + col) = w;
                    }
                }
            }
        } else {
            bf16_t* oh = (bf16_t*)P(6); const void* hin = (const void*)P(7); const float* gate = (const float*)P(8); const float* nw = (const float*)P(9); const float* nsc = (const float*)P(10); float* rowss_out = (float*)P(11); bf16_t* o0 = (bf16_t*)P(2);
            const bool hin32 = P(15) != 0;
            const int bb = u.pm >> 4;
            const int colt = u.pn * BM + wc * 32 + 8 * fq;
            f32x4 gv[2][2], wv[2][2];
#pragma unroll
            for (int bj = 0; bj < 2; ++bj)
#pragma unroll
                for (int n = 0; n < 2; ++n) { const int col = colt + bj * HALF + 4 * n;
                    gv[bj][n] = *(const f32x4*)(gate + (size_t)bb * 6144 + col);
                    if (nw) { const f32x4 a = *(const f32x4*)(nw + col), sc = *(const f32x4*)(nsc + (size_t)bb * 6144 + col); wv[bj][n] = a * (sc + 1.0f); } else wv[bj][n] = (f32x4){0.f, 0.f, 0.f, 0.f}; }
#pragma unroll
            for (int am = 0; am < 4; ++am) { const int ai = am >> 1, m0 = 2 * (am & 1);
#define RES_ROW(H0, H1) do { \
                    const int row = u.pm * BM + ai * HALF + wr * 64 + m * 16 + fr; const size_t off = (size_t)row * 1024 + colt + bj * HALF; \
                    const f32x4 h0 = (H0) + gv[bj][0] * acc[ai][bj][m][0], h1 = (H1) + gv[bj][1] * acc[ai][bj][m][1]; \
                    u32x4 w; w.x = cvt_pk_bf16(h0[0], h0[1]); w.y = cvt_pk_bf16(h0[2], h0[3]); w.z = cvt_pk_bf16(h1[0], h1[1]); w.w = cvt_pk_bf16(h1[2], h1[3]); \
                    *(u32x4*)(oh + off) = w; \
                    const f32x4 q0 = (f32x4){bflo(w.x), bfhi(w.x), bflo(w.y), bfhi(w.y)}, q1 = (f32x4){bflo(w.z), bfhi(w.z), bflo(w.w), bfhi(w.w)}; \
                    sq[m - m0] += ((q0[0] * q0[0] + q0[1] * q0[1]) + (q0[2] * q0[2] + q0[3] * q0[3])) + ((q1[0] * q1[0] + q1[1] * q1[1]) + (q1[2] * q1[2] + q1[3] * q1[3])); \
                    if (nw) { const f32x4 a0 = q0 * wv[bj][0], a1 = q1 * wv[bj][1]; u32x4 v; v.x = cvt_pk_bf16(a0[0], a0[1]); v.y = cvt_pk_bf16(a0[2], a0[3]); v.z = cvt_pk_bf16(a1[0], a1[1]); v.w = cvt_pk_bf16(a1[2], a1[3]); *(u32x4*)(o0 + off) = v; } } while (0)
                float sq[2] = {0.f, 0.f};
                if (hin32) {
                    f32x4 ha[2][2][2];
#pragma unroll
                    for (int m = m0; m < m0 + 2; ++m)
#pragma unroll
                        for (int bj = 0; bj < 2; ++bj)
#pragma unroll
                            for (int n = 0; n < 2; ++n) ha[m - m0][bj][n] = *(const f32x4*)((const float*)hin + (size_t)(u.pm * BM + ai * HALF + wr * 64 + m * 16 + fr) * 1024 + colt + bj * HALF + 4 * n);
                    asm volatile("" ::: "memory");
#pragma unroll
                    for (int m = m0; m < m0 + 2; ++m)
#pragma unroll
                        for (int bj = 0; bj < 2; ++bj) RES_ROW(ha[m - m0][bj][0], ha[m - m0][bj][1]);
                } else {
                    u32x4 hr[2][2];
#pragma unroll
                    for (int m = m0; m < m0 + 2; ++m)
#pragma unroll
                        for (int bj = 0; bj < 2; ++bj) hr[m - m0][bj] = *(const u32x4*)((const bf16_t*)hin + (size_t)(u.pm * BM + ai * HALF + wr * 64 + m * 16 + fr) * 1024 + colt + bj * HALF);
                    asm volatile("" ::: "memory");
#pragma unroll
                    for (int m = m0; m < m0 + 2; ++m)
#pragma unroll
                        for (int bj = 0; bj < 2; ++bj) { const u32x4 x = hr[m - m0][bj]; RES_ROW(((f32x4){bflo(x.x), bfhi(x.x), bflo(x.y), bfhi(x.y)}), ((f32x4){bflo(x.z), bfhi(x.z), bflo(x.w), bfhi(x.w)})); }
                }
#undef RES_ROW
#pragma unroll
                for (int m = m0; m < m0 + 2; ++m) { float t = sq[m - m0]; t += shx(t, 16, fr + 16 * fq); t += shx(t, 32, fr + 16 * fq);
                    if (fq == 0) rowss_out[(size_t)(u.pm * BM + ai * HALF + wr * 64 + m * 16 + fr) * 16 + u.pn * 4 + wc] = t; }
            }
        }
    }
};
}
namespace pg8 {
template <class Epi, class Sched, bool ALIGN_EPI = false, bool SP2 = false>
__device__ __forceinline__ void gemm_phase(PG8_LAS unsigned char* lds, const Gemm g, const Sched& S, const Epi& E) {
    const int tid = otid(), wid = __builtin_amdgcn_readfirstlane(tid >> 6), lane = tid & 63, wr = wid >> 2, wc = wid & 3, fr = lane & 15, fq = lane >> 4;
    const int K = g.K, nt = K / BK;
    unsigned voffA[2], voffB[2];
#pragma unroll
    for (int i = 0; i < 2; ++i) { int R, C; stage_rc(tid * 16 + i * 8192, R, C); const int Rb = g.perm ? ((R & ~31) + perm32(R & 31)) : R;
        voffA[i] = (unsigned)(R * g.lda + C) * 2u; voffB[i] = (unsigned)(Rb * g.ldb + C) * 2u; }
    const size_t kstep = (size_t)(BK * 2);
    const size_t hstepA = (size_t)HALF * g.lda * 2, hstepB = (size_t)HALF * g.ldb * 2;
    const size_t tstepA = 2 * hstepA, tstepB = 2 * hstepB;
    const unsigned ldsw = (unsigned)wid * 1024u;
    const int aoff = lds_byte(wr * 64 + fr, fq * 8), boff = lds_byte(wc * 32 + fr, fq * 8);
#define PG8_SA(b, h) (((b) * 2 + (h)) * HTB)
#define PG8_SB(b, h) ((4 + (b) * 2 + (h)) * HTB)
#define PG8_STAGE(bufoff, gbase, voff) do { _Pragma("unroll") for (int _i = 0; _i < 2; ++_i) \
        __builtin_amdgcn_global_load_lds((const unsigned*)((const char*)(gbase) + (voff)[_i]), (PG8_LAS unsigned*)(lds + (bufoff) + ldsw + _i * 8192), 16, 0, 0); } while (0)
#define PG8_LDA(dst, b, h) do { _Pragma("unroll") for (int m = 0; m < 4; ++m) _Pragma("unroll") for (int k = 0; k < 2; ++k) dst[m][k] = *(const PG8_LAS bf16x8*)(lds + PG8_SA(b, h) + aoff + m * 2048 + k * 1024); } while (0)
#define PG8_LDB(dst, b, h) do { _Pragma("unroll") for (int n = 0; n < 2; ++n) _Pragma("unroll") for (int k = 0; k < 2; ++k) dst[n][k] = *(const PG8_LAS bf16x8*)(lds + PG8_SB(b, h) + boff + n * 2048 + k * 1024); } while (0)
#define PG8_MMA(ai, bj, At, Bt) do { __builtin_amdgcn_s_setprio(1); _Pragma("unroll") for (int m = 0; m < 4; ++m) _Pragma("unroll") for (int n = 0; n < 2; ++n) _Pragma("unroll") for (int k = 0; k < 2; ++k) \
        acc[ai][bj][m][n] = __builtin_amdgcn_mfma_f32_16x16x32_bf16(Bt[n][k], At[m][k], acc[ai][bj][m][n], 0, 0, 0); __builtin_amdgcn_s_setprio(0); } while (0)
#define PG8_WAIT_V(n) asm volatile("s_waitcnt vmcnt(" #n ")" ::: "memory")
#define PG8_WAIT_L(n) asm volatile("s_waitcnt lgkmcnt(" #n ")" ::: "memory")
#define PG8_BAR __builtin_amdgcn_s_barrier()
#define PG8_SCHED __builtin_amdgcn_sched_barrier(0)
    Unit cur, nxt; int ui = 0;
    if (!S.next(0, cur)) return;
    f32x4 acc[2][2][4][2];
#pragma unroll
    for (int a = 0; a < 2; ++a)
#pragma unroll
        for (int b = 0; b < 2; ++b)
#pragma unroll
            for (int m = 0; m < 4; ++m)
#pragma unroll
                for (int n = 0; n < 2; ++n) acc[a][b][m][n] = (f32x4){0.f, 0.f, 0.f, 0.f};
    bf16x8 At[4][2], B0[2][2], B1[2][2];
    const char* cA = (const char*)g.A + (size_t)cur.pm * tstepA; const char* cB = (const char*)g.Bt + (size_t)cur.pn * tstepB;
    S.a_ready(cur);
    if constexpr (SP2) {
        PG8_STAGE(PG8_SB(0, 0), cB, voffB); PG8_STAGE(PG8_SB(0, 1), cB + hstepB, voffB); PG8_STAGE(PG8_SA(0, 0), cA, voffA); PG8_STAGE(PG8_SA(0, 1), cA + hstepA, voffA);
        if (wr == 1) PG8_BAR;
        PG8_WAIT_V(2); PG8_BAR;
        PG8_STAGE(PG8_SB(1, 0), cB + kstep, voffB); PG8_STAGE(PG8_SA(1, 0), cA + kstep, voffA); PG8_STAGE(PG8_SB(1, 1), cB + hstepB + kstep, voffB);
        PG8_WAIT_V(6); PG8_BAR;
    } else {
        PG8_STAGE(PG8_SB(0, 0), cB, voffB); PG8_STAGE(PG8_SA(0, 0), cA, voffA); PG8_STAGE(PG8_SB(0, 1), cB + hstepB, voffB); PG8_STAGE(PG8_SA(0, 1), cA + hstepA, voffA);
        if (wr == 1) PG8_BAR;
        PG8_WAIT_V(4); PG8_BAR;
        PG8_STAGE(PG8_SB(1, 0), cB + kstep, voffB); PG8_STAGE(PG8_SA(1, 0), cA + kstep, voffA); PG8_STAGE(PG8_SB(1, 1), cB + hstepB + kstep, voffB);
        PG8_WAIT_V(6); PG8_BAR;
    }
    for (;;) {
        const bool has_next = S.next(ui + 1, nxt);
        const char* nA = has_next ? (const char*)g.A + (size_t)nxt.pm * tstepA : cA; const char* nB = has_next ? (const char*)g.Bt + (size_t)nxt.pn * tstepB : cB;
        for (int t = 0; t < nt; t += 2) {
            const bool last = (t == nt - 2);
            const char* a1 = cA + (size_t)(t + 1) * kstep;
            const char* a2 = last ? nA : cA + (size_t)(t + 2) * kstep; const char* b2 = last ? nB : cB + (size_t)(t + 2) * kstep;
            const char* a3 = a2 + kstep; const char* b3 = b2 + kstep;
            if (last && has_next) S.a_ready(nxt);
            if constexpr (SP2) {
            PG8_LDB(B0, 0, 0); PG8_LDB(B1, 0, 1); PG8_SCHED; PG8_LDA(At, 0, 0); PG8_STAGE(PG8_SA(1, 1), a1 + hstepA, voffA);
            PG8_WAIT_V(8); PG8_WAIT_L(0); PG8_BAR; PG8_MMA(0, 0, At, B0); PG8_MMA(0, 1, At, B1); PG8_BAR; PG8_SCHED;
            PG8_LDA(At, 0, 1); PG8_STAGE(PG8_SB(0, 0), b2, voffB); PG8_STAGE(PG8_SB(0, 1), b2 + hstepB, voffB); PG8_STAGE(PG8_SA(0, 0), a2, voffA);
            PG8_WAIT_V(8); PG8_WAIT_L(0); PG8_BAR; PG8_MMA(1, 0, At, B0); PG8_MMA(1, 1, At, B1); PG8_BAR; PG8_SCHED;
            PG8_LDB(B0, 1, 0); PG8_LDB(B1, 1, 1); PG8_SCHED; PG8_LDA(At, 1, 0); PG8_STAGE(PG8_SA(0, 1), a2 + hstepA, voffA);
            PG8_WAIT_V(8); PG8_WAIT_L(0); PG8_BAR; PG8_MMA(0, 0, At, B0); PG8_MMA(0, 1, At, B1); PG8_BAR; PG8_SCHED;
            PG8_LDA(At, 1, 1); PG8_STAGE(PG8_SB(1, 0), b3, voffB); PG8_STAGE(PG8_SB(1, 1), b3 + hstepB, voffB); PG8_STAGE(PG8_SA(1, 0), a3, voffA);
            PG8_WAIT_V(8); PG8_WAIT_L(0); PG8_BAR; PG8_MMA(1, 0, At, B0); PG8_MMA(1, 1, At, B1); PG8_BAR; PG8_SCHED;
            } else {
            PG8_LDB(B0, 0, 0); PG8_SCHED; PG8_LDA(At, 0, 0); PG8_STAGE(PG8_SA(1, 1), a1 + hstepA, voffA);
            PG8_WAIT_L(8); PG8_BAR; PG8_WAIT_L(0); PG8_MMA(0, 0, At, B0); PG8_BAR; PG8_SCHED;
            PG8_LDB(B1, 0, 1); PG8_STAGE(PG8_SB(0, 0), b2, voffB);
            PG8_BAR; PG8_WAIT_L(0); PG8_MMA(0, 1, At, B1); PG8_BAR;
            PG8_LDA(At, 0, 1); PG8_STAGE(PG8_SA(0, 0), a2, voffA);
            PG8_BAR; PG8_WAIT_L(0); PG8_MMA(1, 0, At, B0); PG8_BAR; PG8_SCHED;
            PG8_STAGE(PG8_SB(0, 1), b2 + hstepB, voffB);
            PG8_WAIT_V(6); PG8_BAR; PG8_MMA(1, 1, At, B1); PG8_BAR;
            PG8_LDB(B0, 1, 0); PG8_SCHED; PG8_LDA(At, 1, 0); PG8_STAGE(PG8_SA(0, 1), a2 + hstepA, voffA);
            PG8_WAIT_L(8); PG8_BAR; PG8_WAIT_L(0); PG8_MMA(0, 0, At, B0); PG8_BAR; PG8_SCHED;
            PG8_LDB(B1, 1, 1); PG8_STAGE(PG8_SB(1, 0), b3, voffB);
            PG8_BAR; PG8_WAIT_L(0); PG8_MMA(0, 1, At, B1); PG8_BAR;
            PG8_LDA(At, 1, 1); PG8_STAGE(PG8_SA(1, 0), a3, voffA);
            PG8_BAR; PG8_WAIT_L(0); PG8_MMA(1, 0, At, B0); PG8_BAR; PG8_SCHED;
            PG8_STAGE(PG8_SB(1, 1), b3 + hstepB, voffB);
            PG8_WAIT_V(6); PG8_BAR; PG8_MMA(1, 1, At, B1); PG8_BAR;
            }
        }
        if constexpr (ALIGN_EPI) { if (wr == 0) PG8_BAR; }
        if constexpr (!Epi::AFTER_DRAIN) { E(acc, cur, wr, wc, fr, fq); S.done(cur); }
        if (!has_next) break;
#pragma unroll
        for (int a = 0; a < 2; ++a)
#pragma unroll
            for (int b = 0; b < 2; ++b)
#pragma unroll
                for (int m = 0; m < 4; ++m)
#pragma unroll
                    for (int n = 0; n < 2; ++n) acc[a][b][m][n] = (f32x4){0.f, 0.f, 0.f, 0.f};
        cur = nxt; cA = nA; cB = nB; ++ui;
        if constexpr (ALIGN_EPI) { if (wr == 1) PG8_BAR; }
    }
    PG8_WAIT_V(0);
    if constexpr (!ALIGN_EPI) { if (wr == 0) PG8_BAR; }
    PG8_BAR;
    if constexpr (Epi::AFTER_DRAIN) { E.fused(acc, cur, wr, wc, fr, fq, lds, wid, lane); S.done(cur); }
#undef PG8_SA
#undef PG8_SB
#undef PG8_STAGE
#undef PG8_LDA
#undef PG8_LDB
#undef PG8_MMA
#undef PG8_WAIT_V
#undef PG8_WAIT_L
#undef PG8_BAR
#undef PG8_SCHED
}
}
#include <hip/hip_bf16.h>
#include <cmath>
namespace attn_body {
using bf16=__hip_bfloat16;
using bf16x8=__attribute__((ext_vector_type(8)))short;
using s16x4=__attribute__((ext_vector_type(4)))short;
using f32x16=__attribute__((ext_vector_type(16)))float;
using u32x4=__attribute__((ext_vector_type(4)))unsigned;
constexpr int BATCH=8,NHEAD=8,SEQ=4096,D=64,QP=512,KP=128,OP=1024;
constexpr int NW=8,QBLK=32,QB=QBLK*NW,KVBLK=64,NQB=SEQ/QB;
constexpr int ATTN_UNIT_ROWS=QB;
__device__ __forceinline__ int crow(int r,int hi){return (r&3)+8*(r>>2)+4*hi;}
#define SBAR() __builtin_amdgcn_sched_barrier(0)
__device__ __forceinline__ void cmask(f32x16&p0,f32x16&p1,int jb,int qrel,int hi){
  const float NEG=-INFINITY; int kb=64*jb+4*hi;
  #pragma unroll
  for(int r=0;r<16;++r){int kv=kb+(r&3)+8*(r>>2); if(kv>qrel)p0[r]=NEG; if(kv+32>qrel)p1[r]=NEG;}
}

constexpr int NSLOT=3, SLOTB=8192;
constexpr int LDS_K=0, LDS_V=NSLOT*SLOTB, LDS_WS=2*NSLOT*SLOTB, LDS_OST=LDS_WS+NW*64*4, LDS_BYTES=LDS_OST+NW*4096;
constexpr float C2=0.125f*1.4426950408889634f;
__device__ __forceinline__ void glds16(const void*gsrc,unsigned lds_dst){unsigned keep;
  asm volatile("s_mov_b32 %0, m0\n\ts_mov_b32 m0, %2\n\ts_nop 0\n\tglobal_load_lds_dwordx4 %1, off\n\ts_mov_b32 m0, %0":"=&s"(keep):"v"(gsrc),"s"(lds_dst):"memory");}
__device__ __forceinline__ float max3f(float a,float b,float c){float r;asm("v_max3_f32 %0, %1, %2, %3":"=v"(r):"v"(a),"v"(b),"v"(c));return r;}
__device__ __forceinline__ float max2f(float a,float b){float r;asm("v_max_f32_e32 %0, %1, %2":"=v"(r):"v"(a),"v"(b));return r;}
__device__ __forceinline__ float fadd_s(float a,float b){float r;asm("v_add_f32_e32 %0, %1, %2":"=v"(r):"v"(a),"v"(b));return r;}
__device__ __forceinline__ float fsub_s(float a,float b){float r;asm("v_sub_f32_e32 %0, %1, %2":"=v"(r):"v"(a),"v"(b));return r;}
typedef float f32x2_t __attribute__((ext_vector_type(2))); typedef __bf16 bf16x2_t __attribute__((ext_vector_type(2)));
__device__ __forceinline__ unsigned cvtpk_s(float lo,float hi){f32x2_t v={lo,hi};bf16x2_t b=__builtin_convertvector(v,bf16x2_t);return __builtin_bit_cast(unsigned,b);}
#define WAIT_BAR(N) asm volatile("s_waitcnt vmcnt(" #N ") lgkmcnt(0)\n\ts_barrier":::"memory")

__device__ __forceinline__ void qkt(f32x16&p0,f32x16&p1,const char*Kslot,const bf16x8*qr,const f32x16&negm,int r32,int hi){
  const char*kb=Kslot+hi*1024+r32*16;
  #pragma unroll
  for(int d0=0;d0<4;++d0){
    const bf16x8 b0=*reinterpret_cast<const bf16x8*>(kb+d0*2048);
    const bf16x8 b1=*reinterpret_cast<const bf16x8*>(kb+d0*2048+512);
    if(d0==0){p0=__builtin_amdgcn_mfma_f32_32x32x16_bf16(b0,qr[0],negm,0,0,0);p1=__builtin_amdgcn_mfma_f32_32x32x16_bf16(b1,qr[0],negm,0,0,0);}
    else{p0=__builtin_amdgcn_mfma_f32_32x32x16_bf16(b0,qr[d0],p0,0,0,0);p1=__builtin_amdgcn_mfma_f32_32x32x16_bf16(b1,qr[d0],p1,0,0,0);}}
}
typedef __attribute__((address_space(3))) const char* lds_cptr;
typedef short v4i16_t __attribute__((ext_vector_type(4)));
__device__ __forceinline__ void kload8(bf16x8*kf,lds_cptr kp){
  kf[0]=*(const __attribute__((address_space(3))) bf16x8*)(kp);      kf[1]=*(const __attribute__((address_space(3))) bf16x8*)(kp+512);
  kf[2]=*(const __attribute__((address_space(3))) bf16x8*)(kp+2048); kf[3]=*(const __attribute__((address_space(3))) bf16x8*)(kp+2560);
  kf[4]=*(const __attribute__((address_space(3))) bf16x8*)(kp+4096); kf[5]=*(const __attribute__((address_space(3))) bf16x8*)(kp+4608);
  kf[6]=*(const __attribute__((address_space(3))) bf16x8*)(kp+6144); kf[7]=*(const __attribute__((address_space(3))) bf16x8*)(kp+6656);
}
__device__ __forceinline__ void kload2(bf16x8*kf,lds_cptr kp,int j){ kf[2*j]=*(const __attribute__((address_space(3))) bf16x8*)(kp+j*2048); kf[2*j+1]=*(const __attribute__((address_space(3))) bf16x8*)(kp+j*2048+512); }
__device__ __forceinline__ s16x4 vtr(lds_cptr p){ return __builtin_bit_cast(s16x4,__builtin_amdgcn_ds_read_tr16_b64_v4i16((__attribute__((address_space(3))) v4i16_t*)p)); }
__device__ __forceinline__ float rowmax(const f32x16&p0,const f32x16&p1){
  float a=max3f(p0[0],p0[1],p1[0]),b=max3f(p0[2],p0[3],p1[1]);a=max3f(a,p1[2],p1[3]);
  #pragma unroll
  for(int r=4;r<16;r+=4){a=max3f(a,p0[r],p0[r+1]);b=max3f(b,p0[r+2],p0[r+3]);a=max3f(a,p1[r],p1[r+1]);b=max3f(b,p1[r+2],p1[r+3]);}
  const float m=max2f(a,b);
  auto rr=__builtin_amdgcn_permlane32_swap(__float_as_uint(m),__float_as_uint(m),false,false);
  return max2f(__uint_as_float(rr[0]),__uint_as_float(rr[1]));
}
__device__ __forceinline__ void pv(f32x16*o,int vb,bf16x8 pa0,bf16x8 pa1,bf16x8 pa2,bf16x8 pa3){
  #pragma unroll
  for(int d0=0;d0<2;++d0){s16x4 lo[4],hi[4];
    #pragma unroll
    for(int ks=0;ks<4;++ks){
      asm volatile("ds_read_b64_tr_b16 %0,%1 offset:%c2":"=&v"(lo[ks]):"v"(vb),"i"(d0*4096+ks*1024):"memory");
      asm volatile("ds_read_b64_tr_b16 %0,%1 offset:%c2":"=&v"(hi[ks]):"v"(vb),"i"(d0*4096+ks*1024+512):"memory");}
    asm volatile("s_waitcnt lgkmcnt(0)":::"memory");SBAR();
    #define PK(k) (bf16x8){lo[k][0],lo[k][1],lo[k][2],lo[k][3],hi[k][0],hi[k][1],hi[k][2],hi[k][3]}
    o[d0]=__builtin_amdgcn_mfma_f32_32x32x16_bf16(pa0,PK(0),o[d0],0,0,0);
    o[d0]=__builtin_amdgcn_mfma_f32_32x32x16_bf16(pa1,PK(1),o[d0],0,0,0);
    o[d0]=__builtin_amdgcn_mfma_f32_32x32x16_bf16(pa2,PK(2),o[d0],0,0,0);
    o[d0]=__builtin_amdgcn_mfma_f32_32x32x16_bf16(pa3,PK(3),o[d0],0,0,0);
    #undef PK
  }
}

#ifndef ATTN_STORE16
#define ATTN_STORE16(p,v) (*(u32x4*)(p)=(v))
#endif
template<int THRL> __device__ __forceinline__ void attn_unit(int b,int h,int qb,const bf16*Q,const bf16*__restrict__ K,const bf16*__restrict__ V,bf16*O,char*shm){
  const int tid=otid(),lane=tid&63,r32=lane&31,hi=lane>>5; const int wid=__builtin_amdgcn_readfirstlane(tid>>6);
  const long rowbase=(long)b*SEQ; const int q0=qb*QB;
  const bf16*Qw=Q+(rowbase+q0+wid*QBLK)*QP+h*D;
  const bf16*Kh=K+rowbase*KP+(h>>2)*D,*Vh=V+rowbase*KP+(h>>2)*D;
  const unsigned lds0=(unsigned)(uintptr_t)shm;
  float*wsf=(float*)(shm+LDS_WS)+wid*64;
  const bf16*ksrc=Kh+(long)lane*KP+wid*8;
  const bf16*vsrc=Vh+(long)(16*(wid&3)+(lane>>2))*KP+(wid>>2)*32+(lane&3)*8;
  const unsigned kdst=lds0+LDS_K+wid*1024, vdst=lds0+LDS_V+wid*1024;
  #define DMA_K(t,slot) glds16(ksrc+(long)(t)*KVBLK*KP,(unsigned)__builtin_amdgcn_readfirstlane(kdst+(slot)))
  #define DMA_V(t,slot) glds16(vsrc+(long)(t)*KVBLK*KP,(unsigned)__builtin_amdgcn_readfirstlane(vdst+(slot)))
  const int vb0=(int)(lds0+LDS_V)+((lane>>4)&1)*32+(lane&3)*8+(4*hi+((lane&15)>>2))*64;
  const char*Kbase=shm+LDS_K; bf16x8 kf[8];
  const lds_cptr shm3=(lds_cptr)shm; const lds_cptr kp0=shm3+LDS_K+hi*1024+r32*16; const lds_cptr vp0=shm3+LDS_V+((lane>>4)&1)*32+(lane&3)*8+(4*hi+((lane&15)>>2))*64;
  const int NT=SEQ/KVBLK;
  DMA_K(0,0);DMA_V(0,0);DMA_K(1,SLOTB);
  bf16x8 qr[4];
  #pragma unroll
  for(int d0=0;d0<4;++d0)qr[d0]=*reinterpret_cast<const bf16x8*>(&Qw[(long)r32*QP+d0*16+hi*8]);
  float mhat=0.f,l_reg=0.f;f32x16 o[2];o[0]=f32x16{};o[1]=f32x16{};f32x16 negm=f32x16{};asm volatile("":"+v"(negm));

  #define CMASK(P0,P1,t) do{}while(0)
  bool resc=false;
  #define START(P0,P1) do{ const float rm=rowmax(P0,P1); resc=false; \
    { const float dl=rm; mhat=fadd_s(mhat,dl); \
      _Pragma("unroll") for(int r=0;r<16;++r){P0[r]=fsub_s(P0[r],dl);P1[r]=fsub_s(P1[r],dl);} \
      _Pragma("unroll") for(int r=0;r<16;++r)negm[r]=-mhat; asm volatile("":"+v"(negm)); } \
    _Pragma("unroll") for(int r=0;r<16;++r)P0[r]=__builtin_amdgcn_exp2f(P0[r]); }while(0)
  #define RESC() do{ if(resc){ asm volatile("s_waitcnt lgkmcnt(0)":::"memory"); \
      _Pragma("unroll") for(int d_=0;d_<2;++d_) _Pragma("unroll") for(int r=0;r<16;++r)o[d_][r]*=wsf[crow(r,hi)]; } }while(0)
  f32x16 pA0,pA1,pB0,pB1;
  int sl_prev=0,sl_cur=0,sl_next=SLOTB;
  #define ROT() do{sl_prev=sl_cur;sl_cur=sl_next;sl_next=(sl_next==(NSLOT-1)*SLOTB)?0:sl_next+SLOTB;}while(0)
  DMA_K(2,2*SLOTB);
  WAIT_BAR(3);
  qkt(pA0,pA1,Kbase,qr,negm,r32,hi);asm volatile("s_nop 15\n\ts_nop 7":"+v"(pA0),"+v"(pA1));CMASK(pA0,pA1,0);
  START(pA0,pA1);
  _Pragma("unroll") for(int r=0;r<16;++r)pA1[r]=__builtin_amdgcn_exp2f(pA1[r]);
  WAIT_BAR(0);
  DMA_K(3,0);DMA_V(1,SLOTB);
  ROT();
  kload8(kf,kp0+sl_cur);
  WAIT_BAR(2);
  s16x4 vlo[8],vhi[8]; u32x4 pw0,pw1,pw2,pw3;
  #define PKW(P,B) cvtpk_s(P[B],P[B+1])
  #define PAF(k) __builtin_bit_cast(bf16x8,pw##k)
  #define VFR(i) (bf16x8){vlo[i][0],vlo[i][1],vlo[i][2],vlo[i][3],vhi[i][0],vhi[i][1],vhi[i][2],vhi[i][3]}
  #define PIN(x) asm volatile("":"+v"(x))
  #define MX3(a,b,c) __builtin_fmaxf(__builtin_fmaxf((a),(b)),(c))
  #define GAPA(MF,A0,A1,A2,A3,W0,W1,PW) do{ MF; sacc+=A0; sacc+=A1; sacc+=A2; sacc+=A3; PIN(sacc); W0; W1; PIN(PW); SBAR(); }while(0)
  #define EX(v) __builtin_amdgcn_exp2f(v)
  #define GAPB(MF,X,B) do{ MF; X[B]=EX(X[B]); X[B+1]=EX(X[B+1]); X[B+2]=EX(X[B+2]); X[B+3]=EX(X[B+3]); PIN(X); SBAR(); }while(0)
  #define VRD(i) do{ vlo[i]=vtr(vp_+(((i)>>2)*4096+((i)&3)*1024)); vhi[i]=vtr(vp_+(((i)>>2)*4096+((i)&3)*1024+512)); }while(0)
  #define KRD(G,j) do{ if(G){ kload2(kf,kp0+sl_next,j); SBAR(); } }while(0)
  #define STEP(C0,C1,P0,P1,t,GK,GV,GL) do{ SBAR(); \
    const lds_cptr vp_=vp0+sl_prev; \
    VRD(0); SBAR(); float sacc=(P0[0]+P0[1]); \
    GAPA(C0=__builtin_amdgcn_mfma_f32_32x32x16_bf16(kf[0],qr[0],negm,0,0,0), P0[2],P0[3],P0[4],P0[5],     pw0[0]=PKW(P0,0), pw0[1]=PKW(P0,2), pw0); \
    VRD(4); SBAR(); GAPA(C1=__builtin_amdgcn_mfma_f32_32x32x16_bf16(kf[1],qr[0],negm,0,0,0), P0[6],P0[7],P0[8],P0[9],     pw0[2]=PKW(P0,4), pw0[3]=PKW(P0,6), pw0); \
    VRD(1); SBAR(); GAPA(C0=__builtin_amdgcn_mfma_f32_32x32x16_bf16(kf[2],qr[1],C0,0,0,0),   P0[10],P0[11],P0[12],P0[13], pw1[0]=PKW(P0,8), pw1[1]=PKW(P0,10), pw1); \
    VRD(5); SBAR(); GAPA(C1=__builtin_amdgcn_mfma_f32_32x32x16_bf16(kf[3],qr[1],C1,0,0,0),   P0[14],P0[15],P1[0],P1[1],   pw1[2]=PKW(P0,12),pw1[3]=PKW(P0,14), pw1); \
    VRD(2); SBAR(); GAPA(C0=__builtin_amdgcn_mfma_f32_32x32x16_bf16(kf[4],qr[2],C0,0,0,0),   P1[2],P1[3],P1[4],P1[5],     pw2[0]=PKW(P1,0), pw2[1]=PKW(P1,2), pw2); \
    VRD(6); SBAR(); GAPA(C1=__builtin_amdgcn_mfma_f32_32x32x16_bf16(kf[5],qr[2],C1,0,0,0),   P1[6],P1[7],P1[8],P1[9],     pw2[2]=PKW(P1,4), pw2[3]=PKW(P1,6), pw2); \
    VRD(3); SBAR(); GAPA(C0=__builtin_amdgcn_mfma_f32_32x32x16_bf16(kf[6],qr[3],C0,0,0,0),   P1[10],P1[11],P1[12],P1[13], pw3[0]=PKW(P1,8), pw3[1]=PKW(P1,10), pw3); \
    VRD(7); SBAR(); GAPA(C1=__builtin_amdgcn_mfma_f32_32x32x16_bf16(kf[7],qr[3],C1,0,0,0),   P1[14],P1[15],0.f,0.f,       pw3[2]=PKW(P1,12),pw3[3]=PKW(P1,14), pw3); \
    l_reg+=sacc; \
    if(GK){DMA_K((t)+3,sl_cur);} if(GV){DMA_V((t)+1,sl_next);} \
    CMASK(C0,C1,t); \
    { float a=MX3(C0[0],C0[1],C1[0]),b=MX3(C0[2],C0[3],C1[1]); a=MX3(a,C1[2],C1[3]); \
      _Pragma("unroll") for(int r=4;r<16;r+=4){a=MX3(a,C0[r],C0[r+1]);b=MX3(b,C0[r+2],C0[r+3]);a=MX3(a,C1[r],C1[r+1]);b=MX3(b,C1[r+2],C1[r+3]);} \
      float rm=__builtin_fmaxf(a,b); { auto rr=__builtin_amdgcn_permlane32_swap(__float_as_uint(rm),__float_as_uint(rm),false,false); rm=__builtin_fmaxf(__uint_as_float(rr[0]),__uint_as_float(rr[1])); } \
      resc=false; \
      if(__builtin_expect(__any(rm>(float)THRL),0)){ const float dl=__builtin_fmaxf(rm,0.f); mhat+=dl; \
        _Pragma("unroll") for(int r=0;r<16;++r){C0[r]-=dl;C1[r]-=dl;} \
        _Pragma("unroll") for(int r=0;r<16;++r)negm[r]=-mhat; asm volatile("":"+v"(negm)); \
        const float f=__builtin_amdgcn_exp2f(-dl); l_reg*=f; if(hi==0)wsf[r32]=f; resc=true; } } \
    SBAR(); \
    GAPB(o[0]=__builtin_amdgcn_mfma_f32_32x32x16_bf16(PAF(0),VFR(0),o[0],0,0,0), C0,0); \
    GAPB(o[1]=__builtin_amdgcn_mfma_f32_32x32x16_bf16(PAF(0),VFR(4),o[1],0,0,0), C0,4); \
    KRD(GL,0); GAPB(o[0]=__builtin_amdgcn_mfma_f32_32x32x16_bf16(PAF(1),VFR(1),o[0],0,0,0), C0,8); \
    KRD(GL,1); GAPB(o[1]=__builtin_amdgcn_mfma_f32_32x32x16_bf16(PAF(1),VFR(5),o[1],0,0,0), C0,12); \
    KRD(GL,2); GAPB(o[0]=__builtin_amdgcn_mfma_f32_32x32x16_bf16(PAF(2),VFR(2),o[0],0,0,0), C1,0); \
    KRD(GL,3); GAPB(o[1]=__builtin_amdgcn_mfma_f32_32x32x16_bf16(PAF(2),VFR(6),o[1],0,0,0), C1,4); \
    GAPB(o[0]=__builtin_amdgcn_mfma_f32_32x32x16_bf16(PAF(3),VFR(3),o[0],0,0,0), C1,8); \
    GAPB(o[1]=__builtin_amdgcn_mfma_f32_32x32x16_bf16(PAF(3),VFR(7),o[1],0,0,0), C1,12); \
    }while(0)
  int t=1;
  #undef CMASK
  #define CMASK(P0,P1,t) do{}while(0)
  for(;t+5<NT;t+=2){
    STEP(pB0,pB1,pA0,pA1,t,true,true,true);     WAIT_BAR(2); RESC(); ROT();
    STEP(pA0,pA1,pB0,pB1,t+1,true,true,true);   WAIT_BAR(2); RESC(); ROT();
  }
  #undef CMASK
  #define CMASK(P0,P1,t) do{}while(0)
  #define ENDW(tt) do{ if((tt)+3<NT){WAIT_BAR(2);} else if((tt)+2<NT){WAIT_BAR(1);} else {WAIT_BAR(0);} }while(0)
  for(;t+1<NT;t+=2){
    STEP(pB0,pB1,pA0,pA1,t,(t+3<NT),(t+1<NT),(t+1<NT));       ENDW(t);   RESC(); ROT();
    STEP(pA0,pA1,pB0,pB1,t+1,(t+4<NT),(t+2<NT),(t+2<NT));     ENDW(t+1); RESC(); ROT();
  }
  STEP(pB0,pB1,pA0,pA1,NT-1,false,false,false); RESC();
  { float sacc=pB0[0]+pB0[1]; _Pragma("unroll") for(int r=2;r<16;++r)sacc+=pB0[r]; _Pragma("unroll") for(int r=0;r<16;++r)sacc+=pB1[r]; l_reg+=sacc;
    pw0=(u32x4){PKW(pB0,0),PKW(pB0,2),PKW(pB0,4),PKW(pB0,6)};pw1=(u32x4){PKW(pB0,8),PKW(pB0,10),PKW(pB0,12),PKW(pB0,14)};pw2=(u32x4){PKW(pB1,0),PKW(pB1,2),PKW(pB1,4),PKW(pB1,6)};pw3=(u32x4){PKW(pB1,8),PKW(pB1,10),PKW(pB1,12),PKW(pB1,14)};
    SBAR(); pv(o,vb0+sl_cur,PAF(0),PAF(1),PAF(2),PAF(3)); }
  #undef PKW
  #undef PAF
  #undef VFR
  #undef PIN
  #undef MX3
  #undef GAPA
  #undef GAPB
  #undef EX
  #undef VRD
  #undef KRD
  #undef STEP
  #undef ENDW
  {auto rr=__builtin_amdgcn_permlane32_swap(__float_as_uint(l_reg),__float_as_uint(l_reg),false,false);l_reg=__uint_as_float(rr[0])+__uint_as_float(rr[1]);}
  if(hi==0)wsf[32+r32]=l_reg;asm volatile("s_waitcnt lgkmcnt(0)":::"memory");
  float rli[16];
  #pragma unroll
  for(int r=0;r<16;++r)rli[r]=__builtin_amdgcn_rcpf(wsf[32+crow(r,hi)]);
  bf16*Ow=O+(rowbase+q0+wid*QBLK)*OP+h*D;
  { bf16*stg=(bf16*)(shm+LDS_OST)+wid*2048;
    #pragma unroll
    for(int r=0;r<16;++r){const int orow=crow(r,hi);
      #pragma unroll
      for(int d0=0;d0<2;++d0)stg[orow*64+d0*32+r32]=__float2bfloat16(o[d0][r]*rli[r]);}
    asm volatile("s_waitcnt lgkmcnt(0)":::"memory");
    #pragma unroll
    for(int i=0;i<4;++i){const int row=i*8+(lane>>3),ch=lane&7; const u32x4 v=*(const u32x4*)(stg+row*64+ch*8); ATTN_STORE16(Ow+(long)row*OP+ch*8,v);} }
  asm volatile("s_waitcnt lgkmcnt(0)\n\ts_barrier":::"memory");
  #undef DMA_K
  #undef DMA_V
  #undef CMASK
  #undef START
  #undef RESC
  #undef ROT
}
constexpr int ATTN_LDS_BYTES=LDS_BYTES;
struct AttnTensors { const bf16* Q; const bf16* K; const bf16* V; bf16* O; };
struct AttnUnit { int bh; int qb; };
struct StaticOrder {
  int vcu, per;
  __device__ __forceinline__ explicit StaticOrder(int grid,int block){ vcu=(grid%8==0)?(block%8)*(grid/8)+block/8:block; per=(1024+grid-1)/grid; }
  __device__ __forceinline__ bool next(int i,AttnUnit&u)const{ if(i>=per)return false; const int idx=vcu*per+i; if(idx>=1024)return false;
    const int bkv=idx>>6, hl=(idx&63)>>4; u.bh=(bkv>>1)*NHEAD+(bkv&1)*4+hl; u.qb=idx&15; return true; }
  __device__ __forceinline__ void a_ready(const AttnUnit&)const{}
  __device__ __forceinline__ void done(const AttnUnit&)const{}
};
template<class Sched,int THRL=8> __device__ __forceinline__ void attn_phase(char*lds,const AttnTensors&T,const Sched&S){
  AttnUnit u;
  for(int i=0;S.next(i,u);++i){ S.a_ready(u); attn_unit<THRL>(u.bh/NHEAD,u.bh%NHEAD,u.qb,T.Q,T.K,T.V,T.O,lds); S.done(u); }
}
#undef SBAR
#undef WAIT_BAR
}
#define GAS __attribute__((address_space(1)))
#define LAS __attribute__((address_space(3)))
typedef unsigned short bf16_t;
typedef unsigned v4u __attribute__((ext_vector_type(4)));
typedef unsigned v2u __attribute__((ext_vector_type(2)));
typedef float f32x4 __attribute__((ext_vector_type(4)));
typedef float f32x16 __attribute__((ext_vector_type(16)));
typedef float f32x2 __attribute__((ext_vector_type(2)));
typedef short bf16x8 __attribute__((ext_vector_type(8)));
using pg8::cvt_pk_bf16; using pg8::bflo; using pg8::bfhi; using pg8::gelu_tanh; using pg8::sigmoidf_;

constexpr int NWAVES = 8, NTHR = 512;
constexpr int BATCH = 8, SEQ = 4096, DM = 1024, MTOK = BATCH * SEQ, DFF = 4096, DEPTH = 4;
constexpr int LDS_BYTES = 147456;
constexpr size_t MiB = 1u << 20;
constexpr size_t WS_ROPE = 512 * 1024, WS_MOD = 1 * MiB, WS_SHW1 = 2 * MiB, WS_SHW2 = WS_SHW1 + 256 * 1024, WS_ROWSS = 3 * MiB, WS_A32 = 5 * MiB;
constexpr size_t WS_WHIN = 6 * MiB, WS_WHOUT = 11 * MiB, WS_WGLU = 15 * MiB, WS_WRIN = 16 * MiB, WS_WROUT = 24 * MiB, WS_W1 = 28 * MiB, WS_W2 = 60 * MiB;
constexpr size_t WS_TT = 92 * MiB, WS_PT = 140 * MiB, WS_HW = 156 * MiB, WS_R = 220 * MiB, WS_END = 476 * MiB;
constexpr size_t R_AP = WS_R, R_Q = WS_R + 48 * MiB, R_K = WS_R + 80 * MiB, R_V = WS_R + 88 * MiB, R_E = WS_R + 96 * MiB, R_G = WS_R + 128 * MiB, R_MIX = WS_R + 192 * MiB;
constexpr size_t R_QP = WS_R + 160 * MiB, R_KP = R_K;
constexpr size_t R_Z = WS_R, R_HF = WS_R + 128 * MiB, R_HID = WS_R;
constexpr size_t TT_LAYER = (size_t)32 * 512 * 768, PT_LAYER = (size_t)32 * 256 * 512;

__device__ __forceinline__ f32x2 mk2(float a, float b) { f32x2 r; r.x = a; r.y = b; return r; }
__device__ __forceinline__ float wave_sum(float v, int lane) {
#pragma unroll
    for (int o = 1; o < 64; o <<= 1) v += shx(v, o, lane);
    return v;
}
__device__ __forceinline__ unsigned f2bf(float f) { unsigned u = __builtin_bit_cast(unsigned, f); return (u + 0x7fffu + ((u >> 16) & 1u)) >> 16; }
__device__ __forceinline__ unsigned pk2(float lo, float hi) { return cvt_pk_bf16(lo, hi); }
__device__ __forceinline__ void dcis(double ang, double& c, double& s) {
    const double n = __builtin_rint(ang * 0.15915494309189535);
    const double r = __builtin_fma(-n, 6.283185307179586, ang);
    const double x = r * 0.0625, x2 = x * x;
    double sn = x * (1.0 + x2 * (-1.0 / 6.0 + x2 * (1.0 / 120.0 + x2 * (-1.0 / 5040.0 + x2 * (1.0 / 362880.0 + x2 * (-1.0 / 39916800.0 + x2 * (1.0 / 6227020800.0)))))));
    double cs = 1.0 + x2 * (-0.5 + x2 * (1.0 / 24.0 + x2 * (-1.0 / 720.0 + x2 * (1.0 / 40320.0 + x2 * (-1.0 / 3628800.0 + x2 * (1.0 / 479001600.0))))));
#pragma unroll
    for (int i = 0; i < 4; ++i) { const double c2 = cs * cs - sn * sn, s2 = 2.0 * cs * sn; cs = c2; sn = s2; }
    c = cs; s = sn;
}
__device__ __forceinline__ double dexp_small(double x) {
    const double y = x * (1.0 / 64.0);
    double e = 1.0 + y * (1.0 + y * (0.5 + y * (1.0 / 6.0 + y * (1.0 / 24.0 + y * (1.0 / 120.0 + y * (1.0 / 720.0 + y * (1.0 / 5040.0 + y * (1.0 / 40320.0))))))));
#pragma unroll
    for (int i = 0; i < 6; ++i) e = e * e;
    return e;
}

__device__ __forceinline__ void p0_transpose_load(f32x4 (&v)[16], const float* W, int N, int item, int lane, bool nt) {
    const int nblk = N / 64, kb = item / nblk, nb = item % nblk, k0 = 64 * kb, n0 = 64 * nb;
#pragma unroll
    for (int i = 0; i < 16; ++i) { const f32x4* p = (const f32x4*)(W + (size_t)(k0 + (lane >> 4) + 4 * i) * N + n0 + 4 * (lane & 15)); v[i] = nt ? __builtin_nontemporal_load(p) : *p; }
}
__device__ __forceinline__ void p0_transpose_store(const f32x4 (&v)[16], int K, int N, bf16_t* WT, LAS float* scr, int item, int lane) {
    const int nblk = N / 64, kb = item / nblk, nb = item % nblk, k0 = 64 * kb, n0 = 64 * nb;
#pragma unroll
    for (int i = 0; i < 16; ++i) { LAS float* d = scr + ((lane >> 4) + 4 * i) * 65 + 4 * (lane & 15); d[0] = v[i][0]; d[1] = v[i][1]; d[2] = v[i][2]; d[3] = v[i][3]; }
    asm volatile("s_waitcnt lgkmcnt(0)" ::: "memory");
    const int c = lane & 7;
#pragma unroll
    for (int j = 0; j < 8; ++j) { const int n = (lane >> 3) + 8 * j; const LAS float* s = scr + (8 * c) * 65 + n;
        v4u o; o.x = pk2(s[0 * 65], s[1 * 65]); o.y = pk2(s[2 * 65], s[3 * 65]); o.z = pk2(s[4 * 65], s[5 * 65]); o.w = pk2(s[6 * 65], s[7 * 65]);
        *(v4u*)(WT + (size_t)(n0 + n) * K + k0 + 8 * c) = o; }
    asm volatile("s_waitcnt lgkmcnt(0)" ::: "memory");
}
__device__ __forceinline__ void skinny_gemm(const LAS float* Al, LAS float* red, const float* W, int ldw, int col0, float* out, int ldo, const float* bias, int tid, bool nt = false) {
    const int wave = tid >> 6, lane = tid & 63;
    float acc[8];
#pragma unroll
    for (int b = 0; b < 8; ++b) acc[b] = 0.f;
    const float* wp = W + (size_t)(128 * wave) * ldw + col0 + lane;
#pragma unroll 4
    for (int k4 = 0; k4 < 32; ++k4) {
        float w0, w1, w2, w3;
        if (nt) { w0 = __builtin_nontemporal_load(wp + (size_t)(4 * k4) * ldw); w1 = __builtin_nontemporal_load(wp + (size_t)(4 * k4 + 1) * ldw); w2 = __builtin_nontemporal_load(wp + (size_t)(4 * k4 + 2) * ldw); w3 = __builtin_nontemporal_load(wp + (size_t)(4 * k4 + 3) * ldw); }
        else { w0 = wp[(size_t)(4 * k4) * ldw]; w1 = wp[(size_t)(4 * k4 + 1) * ldw]; w2 = wp[(size_t)(4 * k4 + 2) * ldw]; w3 = wp[(size_t)(4 * k4 + 3) * ldw]; }
#pragma unroll
        for (int b = 0; b < 8; ++b) { const f32x4 a4 = *(const LAS f32x4*)(Al + b * 1024 + 128 * wave + 4 * k4); acc[b] += (a4[0] * w0 + a4[1] * w1) + (a4[2] * w2 + a4[3] * w3); }
    }
#pragma unroll
    for (int b = 0; b < 8; ++b) red[(wave * 8 + b) * 64 + lane] = acc[b];
    __syncthreads();
    { const int b = tid >> 6; float s = 0.f;
#pragma unroll
      for (int w = 0; w < 8; ++w) s += red[(w * 8 + b) * 64 + lane];
      out[(size_t)b * ldo + col0 + lane] = s + (bias ? bias[col0 + lane] : 0.f); }
    __syncthreads();
}

__device__ __forceinline__ void s5_tables(int e, int g, const float* lam_re, const float* lam_im, const float* log_dt, const float* b_re, const float* b_im, const float* c_re, const float* c_im,
                                          bf16_t* TT, bf16_t* PT, f32x2* A32, LAS unsigned char* lds, int tid) {
    LAS f32x2* PW = (LAS f32x2*)lds;
    LAS f32x2* BB = PW + 2 * 64 * 33;
    LAS f32x2* CC = BB + 2 * 64 * 16;
    LAS float* KF = (LAS float*)(CC + 2 * 16 * 65);
    if (tid < 128) {
        const int d = tid >> 6, p = tid & 63;
        const int li_ = ((e * 2 + d) * 32 + g) * 64 + p;
        const double lr = (double)fminf(lam_re[li_], -1e-4f), li = (double)lam_im[li_];
        const double dt = dexp_small((double)log_dt[(e * 2 + d) * 32 + g] * 0.25); const double dt4 = (dt * dt) * (dt * dt);
        double ar1 = 1.0, ai1 = 0.0;
        for (int tau = 0; tau <= 32; ++tau) {
            const double mag = dexp_small((double)tau * lr * dt4);
            double c, s; dcis((double)tau * li * dt4, c, s);
            PW[(d * 64 + p) * 33 + tau] = mk2((float)(mag * c), (float)(mag * s));
            if (tau == 1) { ar1 = mag * c; ai1 = mag * s; }
            if (tau == 32) A32[(g * 2 + d) * 64 + p] = mk2((float)(mag * c), (float)(mag * s));
        }
        const double den = lr * lr + li * li, nr = ar1 - 1.0;
        const double fre = (nr * lr + ai1 * li) / den, fim = (ai1 * lr - nr * li) / den;
        for (int c = 0; c < 16; ++c) { const double br = (double)b_re[(size_t)li_ * 16 + c], bi = (double)b_im[(size_t)li_ * 16 + c];
            BB[(d * 64 + p) * 16 + c] = mk2((float)(fre * br - fim * bi), (float)(fre * bi + fim * br)); }
    }
#pragma unroll
    for (int i = 0; i < 4; ++i) { const int idx = tid + 512 * i; const int d = idx >> 10, r = idx & 1023;
        const size_t src = (size_t)((e * 2 + d) * 32 + g) * 1024 + r; CC[(idx >> 6) * 65 + (idx & 63)] = mk2(c_re[src], c_im[src]); }
    __syncthreads();
    {   const int d = tid >> 8, c = (tid >> 4) & 15, cp = tid & 15;
        float kacc[32];
#pragma unroll
        for (int t = 0; t < 32; ++t) kacc[t] = 0.f;
        for (int p = 0; p < 64; ++p) {
            const f32x2 cc = CC[(d * 16 + c) * 65 + p], bb = BB[(d * 64 + p) * 16 + cp];
            const float cbr = cc.x * bb.x - cc.y * bb.y, cbi = cc.x * bb.y + cc.y * bb.x;
#pragma unroll
            for (int t = 0; t < 32; ++t) { const f32x2 pw = PW[(d * 64 + p) * 33 + t]; kacc[t] += cbr * pw.x - cbi * pw.y; }
        }
#pragma unroll
        for (int t = 0; t < 32; ++t) KF[(d * 32 + t) * 260 + c * 16 + cp] = kacc[t];
    }
    __syncthreads();
    for (int i = 0; i < 64; ++i) {
        const int idx = tid + 512 * i, n = idx >> 6, ch = idx & 63, sl = ch >> 1, cp0 = (ch & 1) * 8, tl = n >> 4, c = n & 15;
        f32x4 va = (f32x4){0.f, 0.f, 0.f, 0.f}, vb = va;
        if (tl >= sl) { const LAS f32x4* s = (const LAS f32x4*)(KF + (tl - sl) * 260 + c * 16 + cp0); va += s[0]; vb += s[1]; }
        if (sl >= tl) { const LAS f32x4* s = (const LAS f32x4*)(KF + (32 + sl - tl) * 260 + c * 16 + cp0); va += s[0]; vb += s[1]; }
        v4u o; o.x = pk2(va[0], va[1]); o.y = pk2(va[2], va[3]); o.z = pk2(vb[0], vb[1]); o.w = pk2(vb[2], vb[3]);
        *(v4u*)(TT + ((size_t)(g * 512 + n) * 768 + sl * 16 + cp0)) = o;
    }
    for (int i = 0; i < 32; ++i) {
        const int n = tid, ch = i, col0 = ch * 8, q = col0 >> 6, p0 = col0 & 63, d = q >> 1, tl = n >> 4, c = n & 15;
        const int tau = d == 0 ? tl + 1 : 32 - tl;
        float v[8];
#pragma unroll
        for (int j = 0; j < 8; ++j) { const f32x2 cc = CC[(d * 16 + c) * 65 + p0 + j], pw = PW[(d * 64 + p0 + j) * 33 + tau];
            const float wr_ = cc.x * pw.x - cc.y * pw.y, wi_ = cc.x * pw.y + cc.y * pw.x; v[j] = (q & 1) ? -wi_ : wr_; }
        v4u o; o.x = pk2(v[0], v[1]); o.y = pk2(v[2], v[3]); o.z = pk2(v[4], v[5]); o.w = pk2(v[6], v[7]);
        *(v4u*)(TT + ((size_t)(g * 512 + n) * 768 + 512 + col0)) = o;
    }
    for (int i = 0; i < 32; ++i) {
        const int idx = tid + 512 * i, n = idx >> 6, ch = idx & 63, sl = ch >> 1, cp0 = (ch & 1) * 8, d = n >> 7, ri = (n >> 6) & 1, p = n & 63;
        const int tau = d == 0 ? 31 - sl : sl;
        const f32x2 pw = PW[(d * 64 + p) * 33 + tau];
        float v[8];
#pragma unroll
        for (int j = 0; j < 8; ++j) { const f32x2 bb = BB[(d * 64 + p) * 16 + cp0 + j]; v[j] = ri ? (pw.x * bb.y + pw.y * bb.x) : (pw.x * bb.x - pw.y * bb.y); }
        v4u o; o.x = pk2(v[0], v[1]); o.y = pk2(v[2], v[3]); o.z = pk2(v[4], v[5]); o.w = pk2(v[6], v[7]);
        *(v4u*)(PT + ((size_t)(g * 256 + n) * 512 + sl * 16 + cp0)) = o;
    }
    __syncthreads();
}

__device__ __forceinline__ void rope_table(f32x2* gtab, int tid) {
    for (int idx = tid; idx < 1024; idx += NTHR) { const int pos = idx >> 4, f = idx & 15;
        const float invf = __builtin_amdgcn_exp2f(-(float)f * (13.287712379549449f / 16.0f));
        double c, s; dcis((double)((float)pos * invf), c, s); gtab[idx] = mk2((float)c, (float)s); }
}
__device__ __forceinline__ void qkprep_phase(const bf16_t* Q, const bf16_t* Kb, bf16_t* Qo, bf16_t* Ko, const float* qn, const float* kn, const f32x2* gtab, LAS unsigned char* lds, int tid, int gw, int ngw, int it_end, int k_lo, int k_hi) {
    LAS f32x2* tab = (LAS f32x2*)lds;
    for (int idx = tid; idx < 1024; idx += NTHR) tab[idx] = gtab[idx];
    __syncthreads();
    const int lane = tid & 63, j = lane & 7;
    const int axis = j >> 2, fb = (j & 1) * 8; const bool second = (j & 2) != 0;
    const float C2 = 0.125f * 1.4426950408889634f;
    const int wv_ = tid >> 6;
    const f32x4 qw0 = *(const f32x4*)(qn + j * 8), qw1 = *(const f32x4*)(qn + j * 8 + 4), kw0 = *(const f32x4*)(kn + j * 8), kw1 = *(const f32x4*)(kn + j * 8 + 4);
    for (int it0 = gw; ; it0 += 4 * ngw) {
        int itv[4]; bool any = false;
#pragma unroll
        for (int u = 0; u < 4; ++u) { const int i0_ = it0 + u * ngw; int it = i0_;
            if (i0_ >= it_end) { it = MTOK + k_lo + wv_ + ((i0_ - it_end) / ngw) * NWAVES; if (it >= MTOK + k_hi) it = -1; }
            itv[u] = it; any = any || it >= 0; }
        if (!any) break;
        v4u raw[4];
#pragma unroll
        for (int u = 0; u < 4; ++u) { const int it = itv[u]; raw[u] = (v4u){0u, 0u, 0u, 0u};
            if (it >= 0) raw[u] = (it < MTOK) ? *(const v4u*)(Q + (size_t)it * 512 + lane * 8) : *(const v4u*)(Kb + (size_t)((it - MTOK) * 4 + (lane >> 4)) * 128 + (lane & 15) * 8); }
#pragma unroll
        for (int u = 0; u < 4; ++u) { const int it = itv[u]; if (it < 0) continue;
            const bool isq = it < MTOK;
            const int tok = isq ? it : (it - MTOK) * 4 + (lane >> 4);
            bf16_t* optr = isq ? Qo + (size_t)tok * 512 + lane * 8 : Ko + (size_t)tok * 128 + (lane & 15) * 8;
            const float scale = isq ? C2 : 1.0f;
            const f32x4 w0 = isq ? qw0 : kw0, w1 = isq ? qw1 : kw1;
            const int s = tok & 4095, pos = axis == 0 ? (s >> 6) : (s & 63);
            const v4u rw = raw[u];
            float x[8] = {bflo(rw.x), bfhi(rw.x), bflo(rw.y), bfhi(rw.y), bflo(rw.z), bfhi(rw.z), bflo(rw.w), bfhi(rw.w)};
            float ss = 0.f;
#pragma unroll
            for (int i = 0; i < 8; ++i) ss += x[i] * x[i];
            ss += shx(ss, 1, lane); ss += shx(ss, 2, lane); ss += shx(ss, 4, lane);
            const float rs = __builtin_amdgcn_rsqf(ss * (1.0f / 64.0f) + 1e-6f);
            float y[8], o[8];
#pragma unroll
            for (int i = 0; i < 8; ++i) y[i] = x[i] * rs * (i < 4 ? w0[i] : w1[i - 4]);
#pragma unroll
            for (int i = 0; i < 8; ++i) { const float pr = shx(y[i], 2, lane); const f32x2 cs = tab[pos * 16 + fb + i];
                o[i] = (second ? (y[i] * cs.x + pr * cs.y) : (y[i] * cs.x - pr * cs.y)) * scale; }
            v4u w; w.x = cvt_pk_bf16(o[0], o[1]); w.y = cvt_pk_bf16(o[2], o[3]); w.z = cvt_pk_bf16(o[4], o[5]); w.w = cvt_pk_bf16(o[6], o[7]);
            *(v4u*)optr = w; }
    }
}

__device__ __forceinline__ void s5_scan_phase(const float* E, bf16_t* AP, const f32x2* A32, LAS unsigned char* lds, int tid, int it_begin, int it_end, int it_step) {
    LAS f32x2* XC = (LAS f32x2*)lds;
    for (int it = it_begin; it < it_end; it += it_step) {
        const int g = it & 31, b = it >> 5;
        const int st = tid & 127, seg = tid >> 7, d = st >> 6, p = st & 63;
        const f32x2 a = A32[(g * 2 + d) * 64 + p];
        const float* Eb = E + (size_t)(g * 1024 + b * 128) * 256 + d * 128 + p;
        bf16_t* Hb = AP + (size_t)(g * 1024 + b * 128) * 768 + 512 + d * 128 + p;
        float er[32], ei[32];
#pragma unroll
        for (int j = 0; j < 32; ++j) { const int q = 32 * seg + j, k = d ? 127 - q : q; er[j] = Eb[(size_t)k * 256]; ei[j] = Eb[(size_t)k * 256 + 64]; }
        float hr = 0.f, hi = 0.f;
#pragma unroll
        for (int j = 0; j < 32; ++j) { const float xr = er[j], xi = ei[j]; er[j] = hr; ei[j] = hi; const float nr = a.x * hr - a.y * hi + xr, ni = a.x * hi + a.y * hr + xi; hr = nr; hi = ni; }
        XC[seg * 128 + st] = mk2(hr, hi);
        float pr = a.x, pi = a.y;
#pragma unroll
        for (int i = 0; i < 5; ++i) { const float nr = pr * pr - pi * pi, ni = 2.f * pr * pi; pr = nr; pi = ni; }
        __syncthreads();
        float cr = 0.f, ci = 0.f;
        for (int s = 0; s < seg; ++s) { const f32x2 x = XC[s * 128 + st]; const float nr = pr * cr - pi * ci + x.x, ni = pr * ci + pi * cr + x.y; cr = nr; ci = ni; }
#pragma unroll
        for (int j = 0; j < 32; ++j) { const int q = 32 * seg + j, k = d ? 127 - q : q;
            Hb[(size_t)k * 768] = (bf16_t)f2bf(er[j] + cr); Hb[(size_t)k * 768 + 64] = (bf16_t)f2bf(ei[j] + ci);
            const float nr = a.x * cr - a.y * ci, ni = a.x * ci + a.y * cr; cr = nr; ci = ni; }
        __syncthreads();
    }
}

__device__ __forceinline__ float frcp(float x) { return __builtin_amdgcn_rcpf(x); }
__device__ __forceinline__ float fsig(float x) { return frcp(1.0f + __builtin_amdgcn_exp2f(-1.4426950408889634f * x)); }
__device__ __forceinline__ float fgelu(float x) { return x * frcp(1.0f + __builtin_amdgcn_exp2f(x * (-2.3022082f + -0.10294324f * x * x))); }
__device__ __forceinline__ f32x2 fgelu2(f32x2 x) { const f32x2 a = x * (x * x * (-0.10294324f) + (-2.3022082f)); f32x2 e; e.x = __builtin_amdgcn_exp2f(a.x); e.y = __builtin_amdgcn_exp2f(a.y); e = e + 1.0f; f32x2 r; r.x = frcp(e.x); r.y = frcp(e.y); return x * r; }
__device__ __forceinline__ void rglru_phase(int o, const bf16_t* Z, bf16_t* HF, bf16_t* MIX, const float* conv_w, const float* conv_b, const float* ra_w, const float* ra_b,
                                            const float* ix_w, const float* ix_b, const float* lam, LAS unsigned char* lds, int tid, int bid, int G) {
    LAS bf16_t* XA = (LAS bf16_t*)lds;
    LAS float* SA = (LAS float*)(lds + 36864);
    LAS float* SB = SA + 256 * 33;
    LAS float* SEGA = SB + 256 * 33;
    LAS float* SEGB = SEGA + 512;
    LAS float* CAR = SEGB + 512;
    LAS bf16_t* RAW = (LAS bf16_t*)(lds + 36864 + 67584 + 4096 + 256);
    const int wave = tid >> 6, lane = tid & 63, n32 = lane & 31, hi = lane >> 5;
    for (int unit = bid; unit < 256; unit += G) {
        const int b = unit >> 5, hd = (unit & 31) >> 1, hf = unit & 1;
        const int ic0 = 64 * hd, oc0 = ic0 + 32 * hf, cg = tid & 7;
        float cw[4][8], cb[8];
#pragma unroll
        for (int i = 0; i < 8; ++i) { cb[i] = conv_b[o * 1024 + ic0 + 8 * cg + i];
#pragma unroll
            for (int j = 0; j < 4; ++j) cw[j][i] = conv_w[(o * 4 + j) * 1024 + ic0 + 8 * cg + i]; }
        const bf16_t* Zx = Z + (size_t)b * SEQ * 2048 + 1024 + ic0;
#pragma unroll 1
        for (int dir = 0; dir < 2; ++dir) {
            bf16x8 BR[4], BI[4];
#pragma unroll
            for (int ks = 0; ks < 4; ++ks)
#pragma unroll
                for (int i = 0; i < 8; ++i) { const int k = 16 * ks + 8 * hi + i; const size_t off = ((size_t)((o * 2 + dir) * 16 + hd) * 64 + k) * 64 + 32 * hf + n32;
                    BR[ks][i] = (short)f2bf(-1.4426950408889634f * ra_w[off]); BI[ks][i] = (short)f2bf(-1.4426950408889634f * ix_w[off]); }
            const int och = oc0 + n32;
            const float rab = -1.4426950408889634f * ra_b[(o * 2 + dir) * 1024 + och], ixb = -1.4426950408889634f * ix_b[(o * 2 + dir) * 1024 + och];
            const float lm = lam[(o * 2 + dir) * 1024 + och];
            const float sp8 = 8.0f * 1.4426950408889634f * (fmaxf(-lm, 0.f) + log1pf(__expf(-fabsf(lm))));
            if (tid < 32) CAR[tid] = 0.f;
            v4u pre[5];
            {   const int t0 = dir ? 256 * 15 : 0;
#pragma unroll
                for (int k = 0; k < 5; ++k) { const int idx = tid + 512 * k, r = idx >> 3, p8 = idx & 7, ts = t0 - 2 + r;
                    pre[k] = (v4u){0u, 0u, 0u, 0u};
                    if (idx < 2072 && ts >= 0 && ts < SEQ) pre[k] = *(const v4u*)(Zx + (size_t)ts * 2048 + 8 * p8); }
            }
#pragma unroll 1
            for (int ci = 0; ci < 16; ++ci) {
                const int c = dir ? 15 - ci : ci, t0 = 256 * c;
                const int tid = otid(), wave = tid >> 6, lane = tid & 63, n32 = lane & 31, hi = lane >> 5, cg = tid & 7;
#pragma unroll
                for (int k = 0; k < 5; ++k) { const int idx = tid + 512 * k, r = idx >> 3, p8 = idx & 7; if (idx < 2072) *(LAS v4u*)(RAW + r * 72 + 8 * p8) = pre[k]; }
                __syncthreads();
                if (ci < 15) { const int tn = dir ? t0 - 256 : t0 + 256;
#pragma unroll
                    for (int k = 0; k < 5; ++k) { const int idx = tid + 512 * k, r = idx >> 3, p8 = idx & 7, ts = tn - 2 + r;
                        pre[k] = (v4u){0u, 0u, 0u, 0u};
                        if (idx < 2072 && ts >= 0 && ts < SEQ) pre[k] = *(const v4u*)(Zx + (size_t)ts * 2048 + 8 * p8); } }
                v4u gtv[2], hfv[2];
                if (dir) {
#pragma unroll
                    for (int i2 = 0; i2 < 2; ++i2) { const int idx = tid + 512 * i2, tt = idx >> 2, c8 = (idx & 3) * 8; const size_t m = (size_t)b * SEQ + t0 + tt;
                        gtv[i2] = *(const v4u*)(Z + m * 2048 + oc0 + c8); hfv[i2] = *(const v4u*)(HF + m * 1024 + oc0 + c8); } }
#pragma unroll 2
                for (int i4 = 0; i4 < 4; ++i4) {
                    const int tt = (tid >> 3) + 64 * i4;
                    float xc[8];
#pragma unroll
                    for (int i = 0; i < 8; ++i) xc[i] = cb[i];
#pragma unroll
                    for (int j = 0; j < 4; ++j) { const v4u raw = *(const LAS v4u*)(RAW + (tt + j) * 72 + 8 * cg);
                        xc[0] += cw[j][0] * bflo(raw.x); xc[1] += cw[j][1] * bfhi(raw.x); xc[2] += cw[j][2] * bflo(raw.y); xc[3] += cw[j][3] * bfhi(raw.y);
                        xc[4] += cw[j][4] * bflo(raw.z); xc[5] += cw[j][5] * bfhi(raw.z); xc[6] += cw[j][6] * bflo(raw.w); xc[7] += cw[j][7] * bfhi(raw.w); }
                    v4u w; w.x = cvt_pk_bf16(xc[0], xc[1]); w.y = cvt_pk_bf16(xc[2], xc[3]); w.z = cvt_pk_bf16(xc[4], xc[5]); w.w = cvt_pk_bf16(xc[6], xc[7]);
                    *(LAS v4u*)(XA + tt * 72 + 8 * cg) = w;
                    if ((cg >> 2) == hf) {
#pragma unroll
                        for (int i = 0; i < 8; ++i) SB[tt * 33 + (8 * cg - 32 * hf) + i] = xc[i]; }
                }
                __syncthreads();
                f32x16 accR, accI;
#pragma unroll
                for (int r = 0; r < 16; ++r) { accR[r] = rab; accI[r] = ixb; }
#pragma unroll
                for (int ks = 0; ks < 4; ++ks) { const bf16x8 a = *(const LAS bf16x8*)(XA + (32 * wave + n32) * 72 + 16 * ks + 8 * hi);
                    accR = __builtin_amdgcn_mfma_f32_32x32x16_bf16(a, BR[ks], accR, 0, 0, 0); accI = __builtin_amdgcn_mfma_f32_32x32x16_bf16(a, BI[ks], accI, 0, 0, 0); }
#pragma unroll
                for (int r = 0; r < 16; r += 2) { const int t0_ = (32 * wave + (r & 3) + 8 * (r >> 2) + 4 * hi) * 33 + n32, t1_ = t0_ + 33;
                    f32x2 dR, dI; dR.x = __builtin_amdgcn_exp2f(accR[r]); dR.y = __builtin_amdgcn_exp2f(accR[r + 1]); dI.x = __builtin_amdgcn_exp2f(accI[r]); dI.y = __builtin_amdgcn_exp2f(accI[r + 1]);
                    dR = dR + 1.0f; dI = dI + 1.0f;
                    f32x2 rr, ii; rr.x = frcp(dR.x); rr.y = frcp(dR.y); ii.x = frcp(dI.x); ii.y = frcp(dI.y);
                    const f32x2 la = rr * (-sp8);
                    f32x2 av; av.x = __builtin_amdgcn_exp2f(la.x); av.y = __builtin_amdgcn_exp2f(la.y);
                    const f32x2 t2 = (1.0f - av) * (av + 1.0f);
                    f32x2 bm; bm.x = __builtin_amdgcn_sqrtf(t2.x); bm.y = __builtin_amdgcn_sqrtf(t2.y);
                    f32x2 xc; xc.x = SB[t0_]; xc.y = SB[t1_];
                    const f32x2 bo = (bm * ii) * xc;
                    SA[t0_] = av.x; SA[t1_] = av.y; SB[t0_] = bo.x; SB[t1_] = bo.y; }
                __syncthreads();
                {   const int seg = tid >> 5, n = tid & 31;
                    float av[16], bv[16];
                    const int sbase = (dir ? 255 - 16 * seg : 16 * seg) * 33 + n, sstr = dir ? -33 : 33;
#pragma unroll
                    for (int i = 0; i < 16; ++i) { av[i] = SA[sbase + i * sstr]; bv[i] = SB[sbase + i * sstr]; }
                    float A = 1.f, Bv = 0.f;
#pragma unroll
                    for (int i = 0; i < 16; ++i) { Bv = av[i] * Bv + bv[i]; A *= av[i]; }
                    SEGA[seg * 32 + n] = A; SEGB[seg * 32 + n] = Bv;
                    __syncthreads();
                    float h = CAR[(ci & 1) * 32 + n];
                    for (int s = 0; s < seg; ++s) h = SEGA[s * 32 + n] * h + SEGB[s * 32 + n];
#pragma unroll
                    for (int i = 0; i < 16; ++i) { h = av[i] * h + bv[i]; SB[sbase + i * sstr] = h; }
                    if (seg == 15) CAR[((ci + 1) & 1) * 32 + n] = h;
                }
                __syncthreads();
#pragma unroll
                for (int i2 = 0; i2 < 2; ++i2) { const int idx = tid + 512 * i2, tt = idx >> 2, c8 = (idx & 3) * 8; const size_t m = (size_t)b * SEQ + t0 + tt;
                    float hv[8];
#pragma unroll
                    for (int i = 0; i < 8; ++i) hv[i] = SB[tt * 33 + c8 + i];
                    if (dir == 0) { v4u w; w.x = cvt_pk_bf16(hv[0], hv[1]); w.y = cvt_pk_bf16(hv[2], hv[3]); w.z = cvt_pk_bf16(hv[4], hv[5]); w.w = cvt_pk_bf16(hv[6], hv[7]);
                        *(v4u*)(HF + m * 1024 + oc0 + c8) = w; }
                    else { const v4u f = hfv[i2], gt = gtv[i2];
                        const f32x2 p0 = (mk2(hv[0], hv[1]) + mk2(bflo(f.x), bfhi(f.x))) * fgelu2(mk2(bflo(gt.x), bfhi(gt.x)));
                        const f32x2 p1 = (mk2(hv[2], hv[3]) + mk2(bflo(f.y), bfhi(f.y))) * fgelu2(mk2(bflo(gt.y), bfhi(gt.y)));
                        const f32x2 p2 = (mk2(hv[4], hv[5]) + mk2(bflo(f.z), bfhi(f.z))) * fgelu2(mk2(bflo(gt.z), bfhi(gt.z)));
                        const f32x2 p3 = (mk2(hv[6], hv[7]) + mk2(bflo(f.w), bfhi(f.w))) * fgelu2(mk2(bflo(gt.w), bfhi(gt.w)));
                        v4u w; w.x = cvt_pk_bf16(p0.x, p0.y); w.y = cvt_pk_bf16(p1.x, p1.y); w.z = cvt_pk_bf16(p2.x, p2.y); w.w = cvt_pk_bf16(p3.x, p3.y);
                        *(v4u*)(MIX + m * 1024 + oc0 + c8) = w; }
                }
            }
            __syncthreads();
        }
    }
}
#define RLX_AGENT __ATOMIC_RELAXED, __HIP_MEMORY_SCOPE_AGENT
#define XB_TMO      128
#define XB_XCNT(j)  (256  + 64 * (j))
#define XB_XSUB(j)  (1280 + 64 * (j))
#define XB_XGEN(j)  (2304 + 64 * (j))
#define XB_TOP      3328
#define XB_TOPGEN   3392
#define XCD_BAR_WORDS 3456
#define XB_SPIN_CAP (1u << 18)

__device__ __forceinline__ unsigned xb_ld(unsigned* p)              { return __hip_atomic_load(p, __ATOMIC_RELAXED, __HIP_MEMORY_SCOPE_AGENT); }
__device__ __forceinline__ unsigned xb_add(unsigned* p, unsigned v) { return __hip_atomic_fetch_add(p, v, __ATOMIC_RELAXED, __HIP_MEMORY_SCOPE_AGENT); }
__device__ __forceinline__ unsigned xb_xcc_id() { return (unsigned)__builtin_amdgcn_s_getreg((3 << 11) | 20) & 0xFu; }
#define XB_SPIN(cond, bar) do { unsigned _sp = 0; while (cond) { __builtin_amdgcn_s_sleep(1); \
    if ((++_sp & 255u) == 0u) { if (xb_ld(&(bar)[XB_TMO])) break; if (_sp > XB_SPIN_CAP) { atomicAdd(&(bar)[XB_TMO], 1u); break; } } } } while (0)

struct XcdBarrier {
    unsigned* bar; unsigned x;
    volatile LAS unsigned* st;
};

__device__ __forceinline__ XcdBarrier xcd_barrier_post(unsigned* bar, volatile LAS unsigned* st) {
    XcdBarrier b; b.bar = bar; b.x = xb_xcc_id(); b.st = st;
    if (threadIdx.x == 0) (void)xb_add(&bar[XB_XCNT(b.x)], 1u);
    return b;
}
__device__ __forceinline__ void xcd_barrier_complete(unsigned* bar, unsigned x, unsigned& nloc, unsigned& nx) {
    const unsigned G = gridDim.x * gridDim.y * gridDim.z;
    unsigned sum, cnt, mine, sp = 0u;
    for (;;) {
        sum = 0u; cnt = 0u; mine = 0u;
#pragma unroll
        for (unsigned j = 0; j < 16; ++j) { const unsigned c = xb_ld(&bar[XB_XCNT(j)]); sum += c; cnt += (c > 0u) ? 1u : 0u; mine = (j == x) ? c : mine; }
        if (sum == G) break;
        __builtin_amdgcn_s_sleep(1);
        if ((++sp & 255u) == 0u) { if (xb_ld(&bar[XB_TMO])) break; if (sp > XB_SPIN_CAP) { atomicAdd(&bar[XB_TMO], 1u); break; } }
    }
    nloc = mine > 0u ? mine : 1u; nx = cnt > 0u ? cnt : 1u;
}

__device__ __forceinline__ void xcd_barrier(const XcdBarrier& b) {
    asm volatile("s_waitcnt vmcnt(0)" ::: "memory");
    __syncthreads();
    if (threadIdx.x == 0) {
        unsigned* bar = b.bar;
        __builtin_amdgcn_s_waitcnt(0);
        unsigned nloc = b.st[0], nx = b.st[1];
        if (nloc == 0u) { xcd_barrier_complete(bar, b.x, nloc, nx); b.st[0] = nloc; b.st[1] = nx; }
        const unsigned old = xb_add(&bar[XB_XSUB(b.x)], 1u);
        const unsigned gen = old / nloc;
        if (old + 1u == (gen + 1u) * nloc) {
            __builtin_amdgcn_fence(__ATOMIC_RELEASE, "agent");
            asm volatile("s_waitcnt vmcnt(0)" ::: "memory");
            const unsigned og = xb_add(&bar[XB_TOP], 1u);
            const unsigned tg = og / nx;
            if (og + 1u == (tg + 1u) * nx) xb_add(&bar[XB_TOPGEN], 1u);
            else XB_SPIN(xb_ld(&bar[XB_TOPGEN]) == tg, bar);
            __builtin_amdgcn_fence(__ATOMIC_ACQUIRE, "agent");
            xb_add(&bar[XB_XGEN(b.x)], 1u);
            asm volatile("s_waitcnt vmcnt(0)" ::: "memory");
        } else {
            XB_SPIN(xb_ld(&bar[XB_XGEN(b.x)]) == gen, bar);
            __builtin_amdgcn_fence(__ATOMIC_ACQUIRE, "agent");
            asm volatile("s_waitcnt vmcnt(0)" ::: "memory");
        }
    }
    __syncthreads();
}
struct Args { const float* in[31]; float* out; unsigned char* ws; int ph_lo, ph_hi; };
enum { K_P0 = 0, K_P0B, K_INPROJ, K_S5E, K_ATTN, K_S5Y, K_GLU, K_RGLRU, K_OUTPROJ, K_MLP1, K_MLP2, K_FINAL };
constexpr int NPHASE = 29;
#ifndef DUP_PH
#define DUP_PH (-1)
#define NDUP 0
#endif
constexpr int PTAB_OFF = 146432, DESC_OFF = 146432 + 512, MISC_OFF = 146432 + 768;
typedef unsigned long long u64;
__device__ __forceinline__ u64 ldptr(const LAS u64* t, int i) { const u64 v = t[i]; const unsigned lo = __builtin_amdgcn_readfirstlane((unsigned)v), hi = __builtin_amdgcn_readfirstlane((unsigned)(v >> 32)); return ((u64)hi << 32) | lo; }
#define INP(i) ((const float*)ldptr(PTAB, (i)))
#define WSP(T, off) ((T*)(ws + (off)))

__device__ __forceinline__ void shw_item(int it, const LAS u64* PTAB, unsigned char* ws, LAS unsigned char* lds, int tid) {
    LAS float* Al = (LAS float*)lds; LAS float* red = Al + 8192;
    int r = it, ll = 0, n1b = 20;
    for (ll = 0; ll < 4; ++ll) { n1b = (ll & 1) ? 32 : 20; if (r < n1b + 64) break; r -= n1b + 64; }
    const bool first = r < n1b; const int cbk = first ? r : r - n1b;
    const float* shp = WSP(float, WS_MOD) + (size_t)ll * 8 * 6144 + (first ? 0 : 3072);
    __syncthreads();
    for (int i = tid; i < 8192; i += NTHR) Al[i] = shp[(size_t)(i >> 10) * 6144 + (i & 1023)];
    __syncthreads();
    const float* W; int ldw; float* o; int ldo;
    if (first) { if (ll & 1) { W = INP(22) + (size_t)(ll >> 1) * 1024 * 2048; ldw = 2048; } else { W = INP(8) + (size_t)(ll >> 1) * 1024 * 1280; ldw = 1280; } o = WSP(float, WS_SHW1) + (size_t)ll * 8 * 2048; ldo = 2048; }
    else { W = INP(5) + (size_t)ll * 1024 * 4096; ldw = 4096; o = WSP(float, WS_SHW2) + (size_t)ll * 8 * 4096; ldo = 4096; }
    skinny_gemm(Al, red, W, ldw, cbk * 64, o, ldo, nullptr, tid);
}

__global__ void __launch_bounds__(NTHR) fwd_mega(Args args) {
    extern __shared__ __attribute__((aligned(16))) unsigned char lds_raw[];
    LAS unsigned char* lds0 = (LAS unsigned char*)lds_raw;
    cg::grid_group grid = cg::this_grid();
    if (threadIdx.x == 0) { LAS u64* PT0 = (LAS u64*)(lds0 + PTAB_OFF);
#pragma unroll
        for (int i = 0; i < 31; ++i) PT0[i] = (u64)args.in[i];
        PT0[31] = (u64)args.out; PT0[32] = (u64)args.ws;
    }
    if (threadIdx.x < 2) ((LAS unsigned*)(lds0 + MISC_OFF))[threadIdx.x] = 0u;
    __syncthreads();
    const int ph_lo = args.ph_lo, ph_hi = args.ph_hi;
    const XcdBarrier xbar = xcd_barrier_post((unsigned*)args.ws, (volatile LAS unsigned*)(lds0 + MISC_OFF));
    if (args.ph_hi < 0) grid.sync();

    if (ph_lo == 0) {
        const int tid = otid(), lane = tid & 63, wave = __builtin_amdgcn_readfirstlane(tid >> 6);
        const int G = gridDim.x, bid = blockIdx.x;
        const int vcu = (G % 8 == 0) ? (bid % 8) * (G / 8) + bid / 8 : bid;
        const int gw = vcu * NWAVES + wave, NGW = G * NWAVES;
        LAS unsigned char* lds = lds0; LAS u64* PTAB = (LAS u64*)(lds + PTAB_OFF);
        unsigned char* ws = (unsigned char*)ldptr(PTAB, 32);
        if (bid == 0) rope_table(WSP(f32x2, WS_ROPE), tid);

            for (int it = G - 1 - bid; it < 64; it += G) { const int ee = it >> 5, g = it & 31;
                s5_tables(ee, g, INP(9), INP(10), INP(11), INP(12), INP(13), INP(14), INP(15), WSP(bf16_t, WS_TT) + (size_t)ee * TT_LAYER, WSP(bf16_t, WS_PT) + (size_t)ee * PT_LAYER, WSP(f32x2, WS_A32) + ee * 4096, lds, tid); }
            {   LAS float* Al = (LAS float*)lds; LAS float* red = Al + 8192;
                bool loaded = false;
                const int nmw = (G > 128) ? G - 64 : G;
                for (int it = (bid < nmw ? bid : 4 * 96); it < 4 * 96; it += nmw) {
                    if (!loaded) { const float* cvec = INP(1); for (int i = tid; i < 8192; i += NTHR) { const float v = cvec[i]; Al[i] = v / (1.0f + __expf(-v)); } __syncthreads(); loaded = true; }
                    const int ll = it / 96, cbk = it % 96;
                    skinny_gemm(Al, red, INP(3) + (size_t)ll * 1024 * 6144, 6144, cbk * 64, WSP(float, WS_MOD) + (size_t)ll * 8 * 6144, 6144, INP(4) + (size_t)ll * 6144, tid, true);
                }
                __syncthreads();
            }
            {   LAS float* scr = (LAS float*)(lds + wave * 16640);
#pragma unroll 1
                for (int mi = 0; mi < 18; ++mi) {
                    const float* W; bf16_t* WT; int K, N;
                    if (mi < 2)       { W = INP(8) + (size_t)mi * 1024 * 1280; WT = WSP(bf16_t, WS_WHIN) + (size_t)mi * 1280 * 1024; K = 1024; N = 1280; }
                    else if (mi < 4)  { W = INP(21) + (size_t)(mi - 2) * 1024 * 1024; WT = WSP(bf16_t, WS_WHOUT) + (size_t)(mi - 2) * 1024 * 1024; K = 1024; N = 1024; }
                    else if (mi < 6)  { W = INP(17) + (size_t)(mi - 4) * 512 * 512; WT = WSP(bf16_t, WS_WGLU) + (size_t)(mi - 4) * 512 * 512; K = 512; N = 512; }
                    else if (mi < 8)  { W = INP(22) + (size_t)(mi - 6) * 1024 * 2048; WT = WSP(bf16_t, WS_WRIN) + (size_t)(mi - 6) * 2048 * 1024; K = 1024; N = 2048; }
                    else if (mi < 10) { W = INP(30) + (size_t)(mi - 8) * 1024 * 1024; WT = WSP(bf16_t, WS_WROUT) + (size_t)(mi - 8) * 1024 * 1024; K = 1024; N = 1024; }
                    else if (mi < 14) { W = INP(5) + (size_t)(mi - 10) * 1024 * 4096; WT = WSP(bf16_t, WS_W1) + (size_t)(mi - 10) * 4096 * 1024; K = 1024; N = 4096; }
                    else              { W = INP(6) + (size_t)(mi - 14) * 4096 * 1024; WT = WSP(bf16_t, WS_W2) + (size_t)(mi - 14) * 1024 * 4096; K = 4096; N = 1024; }
                    const int nit = (K / 64) * (N / 64);
                    const bool ntw = (mi >= 2 && mi < 6) || (mi >= 8 && mi < 10) || mi >= 14;
                    const bool tsplit = G > 128;
                    const bool smallm = (mi >= 2 && mi < 6) || (mi >= 8 && mi < 10), tabwg = bid >= G - 64;
                    const int itb = tsplit ? (tabwg ? (bid - (G - 64)) * NWAVES + wave : bid * NWAVES + wave) : gw, its = tsplit ? (tabwg ? 64 * NWAVES : (G - 64) * NWAVES) : NGW;
                    if (!tsplit || (tabwg == smallm)) {
                        f32x4 va[16], vb[16];
                        int it = itb;
                        if (it < nit) p0_transpose_load(va, W, N, it, lane, ntw);
                        while (it < nit) {
                            const int itn = it + its;
                            if (itn < nit) p0_transpose_load(vb, W, N, itn, lane, ntw);
                            p0_transpose_store(va, K, N, WT, scr, it, lane);
#pragma unroll
                            for (int i = 0; i < 16; ++i) va[i] = vb[i];
                            it = itn;
                        }
                    }
                }
            }
    }
#pragma unroll 1
    for (int step = (ph_lo > 1 ? ph_lo : 1); step < ph_hi + NDUP; ++step) {
        const int ph = (DUP_PH < 0 || step <= DUP_PH) ? step : (step <= DUP_PH + NDUP ? DUP_PH : step - NDUP);
        const bool merged = (gridDim.x == 256);
        if (merged && (ph == 5 || ph == 18)) continue;
        if (step > ph_lo) xcd_barrier(xbar);
        const int tid = otid(), lane = tid & 63, wave = __builtin_amdgcn_readfirstlane(tid >> 6);
        unsigned lb_ = 0; asm volatile("" : "+s"(lb_));
        LAS unsigned char* lds = lds0 + lb_; LAS u64* PTAB = (LAS u64*)(lds + PTAB_OFF); LAS u64* DESC = (LAS u64*)(lds + DESC_OFF);
        int G = gridDim.x, bid = blockIdx.x;
        asm volatile("" : "+s"(G), "+s"(bid));
        const int vcu = (G % 8 == 0) ? (bid % 8) * (G / 8) + bid / 8 : bid;
        const int gw = vcu * NWAVES + wave, NGW = G * NWAVES;
        u64 wsv_ = ldptr(PTAB, 32), outv_ = ldptr(PTAB, 31);
        asm volatile("" : "+s"(wsv_), "+s"(outv_));
        unsigned char* ws = (unsigned char*)wsv_;
        float* out = (float*)outv_;
        int kind, l = 0;
        if (ph == 0) kind = K_P0; else if (ph == 1) kind = K_P0B; else if (ph == NPHASE - 1) kind = K_FINAL;
        else { int q = ph - 2, sub; if (q < 8) { l = 0; sub = q; } else if (q < 13) { l = 1; sub = q - 8; } else if (q < 21) { l = 2; sub = q - 13; } else { l = 3; sub = q - 21; }
            if ((l & 1) == 0) kind = (sub == 0) ? K_INPROJ : (sub == 1) ? K_S5E : (sub == 2) ? K_ATTN : (sub == 3) ? K_S5Y : (sub == 4) ? K_GLU : (sub == 5) ? K_OUTPROJ : (sub == 6) ? K_MLP1 : K_MLP2;
            else kind = (sub == 0) ? K_INPROJ : (sub == 1) ? K_RGLRU : (sub == 2) ? K_OUTPROJ : (sub == 3) ? K_MLP1 : K_MLP2; }
        const int e = l >> 1;
        const bool even = (l & 1) == 0;

        if (kind == K_P0B) {
            {   for (int it = bid; it < 360; it += G) shw_item(it, PTAB, ws, lds, tid);
            }
            {   const float* x = INP(0); const float* norm_w = INP(2); const float* MOD = WSP(float, WS_MOD); bf16_t* HW = WSP(bf16_t, WS_HW); float* ROWSS = WSP(float, WS_ROWSS);
                const int nheavy = (360 > G) ? (360 - G < G ? 360 - G : G) : 0;
                const int myshare = (bid < nheavy) ? 1 : 2, shbase = (bid < nheavy) ? bid : nheavy + 2 * (bid - nheavy), nshare = nheavy + 2 * (G - nheavy);
                for (int sh = 0; sh < myshare; ++sh)
                for (int m0 = 2 * ((shbase + sh) * NWAVES + wave); m0 < MTOK; m0 += 2 * nshare * NWAVES) {
                    const int b = m0 >> 12;
                    f32x4 v[2][4];
#pragma unroll
                    for (int rr = 0; rr < 2; ++rr)
#pragma unroll
                        for (int j = 0; j < 4; ++j) v[rr][j] = ((const f32x4*)(x + (size_t)(m0 + rr) * DM) + lane)[64 * j];
#pragma unroll
                    for (int rr = 0; rr < 2; ++rr) { const int m = m0 + rr; float ss = 0.f;
#pragma unroll
                        for (int j = 0; j < 4; ++j) { const f32x4 vv = v[rr][j]; ss += (vv[0] * vv[0] + vv[1] * vv[1]) + (vv[2] * vv[2] + vv[3] * vv[3]);
                            const int col = 4 * lane + 256 * j;
                            const f32x4 nw = *(const f32x4*)(norm_w + col), sc = *(const f32x4*)(MOD + (size_t)b * 6144 + 1024 + col);
                            const f32x4 hw = vv * nw * (sc + 1.0f);
                            v2u w; w.x = cvt_pk_bf16(hw[0], hw[1]); w.y = cvt_pk_bf16(hw[2], hw[3]); *(v2u*)(HW + (size_t)m * DM + col) = w; }
                        ss = wave_sum(ss, lane);
                        if (lane < 16) ROWSS[(size_t)m * 16 + lane] = lane == 0 ? ss : 0.f; }
                }
            }
        } else if (kind == K_FINAL) {
            const float* final_w = INP(7); const float* ROWSS = WSP(float, WS_ROWSS); const bf16_t* FIN = WSP(bf16_t, WS_TT);
            for (int m = gw; m < MTOK; m += NGW) {
                const float v = lane < 16 ? ROWSS[(size_t)m * 16 + lane] : 0.f;
                const v4u hraw0 = *((const v4u*)(FIN + (size_t)m * DM) + lane), hraw1 = *((const v4u*)(FIN + (size_t)m * DM) + 64 + lane);
                const float ss = wave_sum(v, lane);
                const float rstd = 1.0f / sqrtf(ss * (1.0f / 1024.0f) + 1e-6f);
#pragma unroll
                for (int j = 0; j < 2; ++j) { const v4u w = j ? hraw1 : hraw0; const int col = 8 * lane + 512 * j;
                    const f32x4 f0 = *(const f32x4*)(final_w + col), f1 = *(const f32x4*)(final_w + col + 4);
                    const f32x4 h0 = (f32x4){bflo(w.x), bfhi(w.x), bflo(w.y), bfhi(w.y)}, h1 = (f32x4){bflo(w.z), bfhi(w.z), bflo(w.w), bfhi(w.w)};
                    *(f32x4*)(out + (size_t)m * DM + col) = h0 * rstd * f0; *(f32x4*)(out + (size_t)m * DM + col + 4) = h1 * rstd * f1; }
            }
        } else if (kind == K_RGLRU) {
            rglru_phase(e, WSP(bf16_t, R_Z), WSP(bf16_t, R_HF), WSP(bf16_t, R_MIX), INP(23), INP(24), INP(25), INP(26), INP(27), INP(28), INP(29), lds, tid, bid, G);
        } else if (kind == K_ATTN) {
#define RUN_ATTN() do { const attn_body::AttnTensors AT{(const attn_body::bf16*)WSP(bf16_t, R_QP), (const attn_body::bf16*)WSP(bf16_t, R_KP), (const attn_body::bf16*)WSP(bf16_t, R_V), (attn_body::bf16*)(WSP(bf16_t, R_MIX) + 512)}; \
                const attn_body::StaticOrder SO(G, bid); attn_body::attn_phase<attn_body::StaticOrder>((char*)lds_raw + lb_, AT, SO); __syncthreads(); } while (0)
#define RUN_S5Y() do { const int pm_ = vcu >> 1, g5_ = pm_ >> 2, b0_ = 2 * (pm_ & 3);     \
                s5_scan_phase(WSP(float, R_E), WSP(bf16_t, R_AP), WSP(f32x2, WS_A32) + e * 4096, lds, tid, b0_ * 32 + g5_, b0_ * 32 + g5_ + 33, 32); \
                asm volatile("s_waitcnt vmcnt(0)" ::: "memory"); __syncthreads(); \
                pg8::Gemm g{}; pg8::Sched S{}; pg8::Epi E{}; \
                S.G = G; S.c = vcu; S.mode = 2; S.nM = 128; S.nN = 2; S.nwg = 256; E.d = DESC; E.mode = pg8::EM_S5Y; \
                g.A = WSP(bf16_t, R_AP); g.lda = 768; g.K = 768; g.perm = 1; g.Bt = WSP(bf16_t, WS_TT) + (size_t)e * TT_LAYER; g.ldb = 768; \
                if (tid == 0) { DESC[2] = (u64)WSP(bf16_t, R_G); DESC[13] = (u64)WSP(bf16_t, R_AP); DESC[12] = (u64)(INP(16) + e * 512); } \
                __syncthreads(); pg8::gemm_phase<pg8::Epi, pg8::Sched, true, true>(lds, g, S, E); __syncthreads(); } while (0)
            if (!merged) {
                s5_scan_phase(WSP(float, R_E), WSP(bf16_t, R_AP), WSP(f32x2, WS_A32) + e * 4096, lds, tid, bid, 256, G);
                RUN_ATTN();
            } else if ((vcu & 2) == 0) { RUN_S5Y(); RUN_ATTN(); }
            else { RUN_ATTN(); RUN_S5Y(); }
#undef RUN_ATTN
#undef RUN_S5Y
        } else {
            pg8::Gemm g{}; pg8::Sched S{}; pg8::Epi E{};
            S.G = G; S.c = bid; S.mode = 0; S.nM = 128; E.d = DESC;
            const float* mod_l = WSP(float, WS_MOD) + (size_t)l * 8 * 6144;
            u64 dv[16];
#pragma unroll
            for (int i = 0; i < 16; ++i) dv[i] = 0;
            if (kind == K_INPROJ) {
                g.A = WSP(bf16_t, WS_HW); g.lda = 1024; g.K = 1024; g.perm = 1; g.ldb = 1024;
                dv[0] = (u64)WSP(float, WS_ROWSS); dv[1] = (u64)(WSP(float, WS_SHW1) + (size_t)l * 8 * 2048); dv[14] = 2048;
                if (even) { g.Bt = WSP(bf16_t, WS_WHIN) + (size_t)e * 1280 * 1024; S.nN = (G == 256) ? 4 : 5; E.mode = pg8::EM_INA; dv[2] = (u64)WSP(bf16_t, R_AP); dv[3] = (u64)WSP(bf16_t, R_Q); dv[4] = (u64)WSP(bf16_t, R_K); dv[5] = (u64)WSP(bf16_t, R_V); }
                else { g.Bt = WSP(bf16_t, WS_WRIN) + (size_t)e * 2048 * 1024; S.nN = 8; E.mode = pg8::EM_INB; dv[2] = (u64)WSP(bf16_t, R_Z); }
            } else if (kind == K_S5E) {
                g.A = WSP(bf16_t, R_AP); g.lda = 768; g.K = 512; g.perm = 0; g.Bt = WSP(bf16_t, WS_PT) + (size_t)e * PT_LAYER; g.ldb = 512;
                S.mode = 1; S.c = vcu; S.nN = 1; E.mode = pg8::EM_S5E; dv[6] = (u64)WSP(float, R_E);
                if (G == 256 && vcu >= 128) {
                    g.A = WSP(bf16_t, WS_HW); g.lda = 1024; g.K = 1024; g.perm = 1; g.Bt = WSP(bf16_t, WS_WHIN) + (size_t)e * 1280 * 1024; g.ldb = 1024;
                    S.mode = 3; E.mode = pg8::EM_INA; dv[6] = 0;
                    dv[0] = (u64)WSP(float, WS_ROWSS); dv[1] = (u64)(WSP(float, WS_SHW1) + (size_t)l * 8 * 2048); dv[14] = 2048;
                    dv[2] = (u64)WSP(bf16_t, R_AP); dv[3] = (u64)WSP(bf16_t, R_Q); dv[4] = (u64)WSP(bf16_t, R_K); dv[5] = (u64)WSP(bf16_t, R_V);
                }
            } else if (kind == K_S5Y) {
                g.A = WSP(bf16_t, R_AP); g.lda = 768; g.K = 768; g.perm = 1; g.Bt = WSP(bf16_t, WS_TT) + (size_t)e * TT_LAYER; g.ldb = 768;
                S.mode = 2; S.c = vcu; S.nN = 2; E.mode = pg8::EM_S5Y; dv[2] = (u64)WSP(bf16_t, R_G); dv[13] = (u64)WSP(bf16_t, R_AP); dv[12] = (u64)(INP(16) + e * 512);
            } else if (kind == K_GLU) {
                g.A = WSP(bf16_t, R_G); g.lda = 512; g.K = 512; g.perm = 1; g.Bt = WSP(bf16_t, WS_WGLU) + (size_t)e * 512 * 512; g.ldb = 512;
                S.nN = 2; E.mode = pg8::EM_GLU; dv[2] = (u64)WSP(bf16_t, R_MIX); dv[13] = (u64)WSP(bf16_t, R_G); dv[12] = (u64)(INP(18) + e * 512);
            } else if (kind == K_OUTPROJ) {
                g.A = WSP(bf16_t, R_MIX); g.lda = 1024; g.K = 1024; g.perm = 1; g.Bt = (even ? WSP(bf16_t, WS_WHOUT) : WSP(bf16_t, WS_WROUT)) + (size_t)e * 1024 * 1024; g.ldb = 1024;
                S.nN = 4; E.mode = pg8::EM_RES; dv[6] = (u64)out; dv[7] = (l == 0) ? (u64)INP(0) : (u64)out; dv[15] = (l == 0) ? 1 : 0; dv[8] = (u64)(mod_l + 2048);
                dv[9] = (u64)(INP(2) + (size_t)(l * 2 + 1) * 1024); dv[10] = (u64)(mod_l + 4096); dv[2] = (u64)WSP(bf16_t, WS_HW); dv[11] = (u64)WSP(float, WS_ROWSS);
            } else if (kind == K_MLP1) {
                g.A = WSP(bf16_t, WS_HW); g.lda = 1024; g.K = 1024; g.perm = 1; g.Bt = WSP(bf16_t, WS_W1) + (size_t)l * 4096 * 1024; g.ldb = 1024;
                S.nN = 16; E.mode = pg8::EM_MLP1; dv[0] = (u64)WSP(float, WS_ROWSS); dv[1] = (u64)(WSP(float, WS_SHW2) + (size_t)l * 8 * 4096); dv[14] = 4096; dv[2] = (u64)WSP(bf16_t, R_HID);
            } else {
                g.A = WSP(bf16_t, R_HID); g.lda = 4096; g.K = 4096; g.perm = 1; g.Bt = WSP(bf16_t, WS_W2) + (size_t)l * 1024 * 4096; g.ldb = 4096;
                S.nN = 4; E.mode = pg8::EM_RES; dv[6] = (l == 3) ? (u64)WSP(bf16_t, WS_TT) : (u64)out; dv[7] = (u64)out; dv[8] = (u64)(mod_l + 5120);
                if (l < 3) { dv[9] = (u64)(INP(2) + (size_t)((l + 1) * 2) * 1024); dv[10] = (u64)(WSP(float, WS_MOD) + (size_t)(l + 1) * 8 * 6144 + 1024); }
                dv[2] = (u64)WSP(bf16_t, WS_HW); dv[11] = (u64)WSP(float, WS_ROWSS);
            }
            __syncthreads();
            if (tid == 0) {
#pragma unroll
                for (int i = 0; i < 16; ++i) DESC[i] = dv[i];
            }
            __syncthreads();
            S.nwg = (S.mode == 1) ? 128 : ((S.mode == 2 || S.mode == 3) ? 256 : S.nM * S.nN);
#ifndef STAG_TICKS
#define STAG_TICKS 0
#endif
#ifndef STAG_RES
#define STAG_RES 0
#endif
            {
                const int stg = (kind == K_OUTPROJ || kind == K_MLP2) ? STAG_RES : (kind == K_MLP1 ? STAG_TICKS : 0);
                const int grp = (bid >> 3) & 3;
                if (stg > 0 && grp) { const u64 t0 = __builtin_amdgcn_s_memrealtime(); while (__builtin_amdgcn_s_memrealtime() - t0 < (u64)(grp * stg)) __builtin_amdgcn_s_sleep(8); }
            }
            pg8::gemm_phase<pg8::Epi, pg8::Sched, true, true>(lds, g, S, E);
            if (kind == K_S5E) { __syncthreads(); asm volatile("s_waitcnt vmcnt(0)" ::: "memory"); __syncthreads();
                const bool kvs = (G == 256);
                const bool qown = kvs && vcu < 128, kown = kvs && vcu >= 128;
                qkprep_phase(WSP(bf16_t, R_Q), WSP(bf16_t, R_K), WSP(bf16_t, R_QP), WSP(bf16_t, R_KP), INP(19) + e * 64, INP(20) + e * 64, WSP(f32x2, WS_ROPE), lds, tid,
                             kvs ? (qown ? vcu * NWAVES + wave : MTOK) : gw, kvs ? 128 * NWAVES : NGW,
                             kvs ? MTOK : MTOK + MTOK / 4, kown ? (vcu - 128) * 64 : 0, kown ? (vcu - 128) * 64 + 64 : 0); }
        }
    }
}

extern "C" void kernel_launch(void* const* d_in, const int* in_sizes, int n_in, void* d_out, int out_size, void* d_ws, size_t ws_size, hipStream_t stream) {
    static int grid = 0;
    if (grid == 0) {
        int dev = 0, cus = 0, per_cu = 0;
        (void)hipGetDevice(&dev); (void)hipDeviceGetAttribute(&cus, hipDeviceAttributeMultiprocessorCount, dev);
        (void)hipFuncSetAttribute((const void*)fwd_mega, hipFuncAttributeMaxDynamicSharedMemorySize, LDS_BYTES);
        (void)hipOccupancyMaxActiveBlocksPerMultiprocessor(&per_cu, (const void*)fwd_mega, NTHR, LDS_BYTES);
        if (per_cu != 1) per_cu = 1;
        (void)hipGetLastError();
        grid = cus * per_cu;
        if (ws_size < WS_END) fprintf(stderr, "kernel_launch: workspace too small: %zu < %zu\n", ws_size, (size_t)WS_END);
        if (n_in != 31) fprintf(stderr, "kernel_launch: expected 31 inputs, got %d\n", n_in);
    }
    (void)hipMemsetAsync(d_ws, 0, 16384, stream);
    Args a{};
    for (int i = 0; i < 31; ++i) a.in[i] = (const float*)d_in[i];
    a.out = (float*)d_out; a.ws = (unsigned char*)d_ws; a.ph_lo = 0; a.ph_hi = NPHASE;
    void* kargs[] = {&a};
    hipError_t err = hipLaunchCooperativeKernel((const void*)fwd_mega, dim3(grid), dim3(NTHR), kargs, LDS_BYTES, stream);
    if (err != hipSuccess) fprintf(stderr, "cooperative launch failed: %s (grid %d)\n", hipGetErrorString(err), grid);
}
```
